# Optimizing an MI355X kernel written in HIP

```python
import jax, jax.numpy as jnp
from jax import lax
import numpy as np

D_MODEL = 1024
BATCH = 8
SEQ = 4096
DEPTH = 4

CTX_LEN = 256
GRID_W = 64
N_MIXERS = 2
N_A_LAYERS = (DEPTH + 1) // 2
N_B_LAYERS = DEPTH // 2
HEAD_DIM = 64
A_Q_HEADS = D_MODEL // HEAD_DIM
A_KV_HEADS = 4
A_QW = A_Q_HEADS * HEAD_DIM
A_KW = A_KV_HEADS * HEAD_DIM
WINDOW = 128
BLOCK = 128
B_HEADS = 16
B_NOPE = 64
B_ROPE = 32
B_V = 64
Q_LORA = 512
KV_LORA = 256
D_FF = 2816
CONV_W = 3
ROPE_BASE = 10000.0
EPS = 1e-6
NEG = -1e30

kernel_name = "hybrid_swa_sink_mla_convglu_prefix_ctx"


def rmsnorm(x, g):
    xf = x.astype(jnp.float32)
    y = xf * lax.rsqrt(jnp.mean(xf * xf, axis=-1, keepdims=True) + EPS)
    return (y * g.astype(jnp.float32)).astype(x.dtype)


def modulate(h, shift, scale):
    return h * (1.0 + scale) + shift


def axial_angles(rows, rot_dim):
    row = jnp.repeat(jnp.arange(rows), GRID_W).astype(jnp.float32)
    col = jnp.tile(jnp.arange(GRID_W), rows).astype(jnp.float32)
    n_freq = rot_dim // 4
    inv = ROPE_BASE ** (-jnp.arange(n_freq, dtype=jnp.float32) / n_freq)
    return jnp.concatenate([row[:, None] * inv, col[:, None] * inv], axis=-1)


def apply_rope(x, ang):
    ang = ang.reshape((ang.shape[0],) + (1,) * (x.ndim - 3) + (ang.shape[-1],))
    cos = jnp.cos(ang).astype(x.dtype)
    sin = jnp.sin(ang).astype(x.dtype)
    x1 = x[..., 0::2]
    x2 = x[..., 1::2]
    return jnp.stack([x1 * cos - x2 * sin, x1 * sin + x2 * cos], axis=-1).reshape(x.shape)


def dwconv_centred(u, w, b):
    up = jnp.pad(u, ((0, 0), (1, 1), (0, 0)))
    return up[:, :-2] * w[0] + up[:, 1:-1] * w[1] + up[:, 2:] * w[2] + b


def conv_glu(h, w_in, conv_w, conv_b, w_out):
    ab = h @ w_in
    a, v = ab[..., :D_FF], ab[..., D_FF:]
    a = dwconv_centred(a, conv_w, conv_b)
    return (jax.nn.silu(a) * v) @ w_out


def window_gqa(h_lat, h_ctx, wqkv, wo, sink, ang, with_ctx_out):
    B, S, _ = h_lat.shape
    L = h_ctx.shape[1]
    G = A_Q_HEADS // A_KV_HEADS
    scale = HEAD_DIM ** -0.5

    def proj(h):
        n = h.shape[1]
        qkv = h @ wqkv
        q = qkv[..., :A_QW].reshape(B, n, A_KV_HEADS, G, HEAD_DIM)
        k = qkv[..., A_QW:A_QW + A_KW].reshape(B, n, A_KV_HEADS, HEAD_DIM)
        v = qkv[..., A_QW + A_KW:].reshape(B, n, A_KV_HEADS, HEAD_DIM)
        return q, k, v

    q_lat, k_lat, v_lat = proj(h_lat)
    q_lat = apply_rope(q_lat, ang) * scale
    k_lat = apply_rope(k_lat, ang)
    q_ctx, k_ctx, v_ctx = proj(h_ctx)
    sink_f = sink.astype(jnp.float32).reshape(A_KV_HEADS, G)[None, :, :, None, None]

    nb = S // BLOCK
    kv_len = BLOCK + 2 * WINDOW
    kp = jnp.pad(k_lat, ((0, 0), (WINDOW, WINDOW), (0, 0), (0, 0)))
    vp = jnp.pad(v_lat, ((0, 0), (WINDOW, WINDOW), (0, 0), (0, 0)))

    def block(i):
        q0 = i * BLOCK
        qb = lax.dynamic_slice_in_dim(q_lat, q0, BLOCK, axis=1)
        kb = lax.dynamic_slice_in_dim(kp, q0, kv_len, axis=1)
        vb = lax.dynamic_slice_in_dim(vp, q0, kv_len, axis=1)
        s_win = jnp.einsum('bqkgd,bskd->bkgqs', qb, kb).astype(jnp.float32)
        qpos = q0 + jnp.arange(BLOCK)
        kpos = q0 - WINDOW + jnp.arange(kv_len)
        valid = (jnp.abs(qpos[:, None] - kpos[None, :]) <= WINDOW) & (kpos >= 0) & (kpos < S)
        s_win = jnp.where(valid, s_win, NEG)
        s_ctx = jnp.einsum('bqkgd,bskd->bkgqs', qb, k_ctx).astype(jnp.float32)
        s_snk = jnp.broadcast_to(sink_f, s_win.shape[:-1] + (1,))
        p = jax.nn.softmax(jnp.concatenate([s_win, s_ctx, s_snk], axis=-1), axis=-1)
        o = (jnp.einsum('bkgqs,bskd->bqkgd', p[..., :kv_len].astype(vb.dtype), vb)
             + jnp.einsum('bkgqs,bskd->bqkgd', p[..., kv_len:kv_len + L].astype(v_ctx.dtype), v_ctx))
        return o.reshape(B, BLOCK, A_QW)

    o_lat = lax.map(block, jnp.arange(nb))
    o_lat = o_lat.transpose(1, 0, 2, 3).reshape(B, S, A_QW)
    out_lat = o_lat @ wo
    if not with_ctx_out:
        return out_lat, None
    s = jnp.einsum('bqkgd,bskd->bkgqs', q_ctx * scale, k_ctx).astype(jnp.float32)
    s_snk = jnp.broadcast_to(sink_f, s.shape[:-1] + (1,))
    p = jax.nn.softmax(jnp.concatenate([s, s_snk], axis=-1), axis=-1)[..., :-1]
    o_ctx = jnp.einsum('bkgqs,bskd->bqkgd', p.astype(v_ctx.dtype), v_ctx).reshape(B, L, A_QW)
    return out_lat, o_ctx @ wo


def mla(h_lat, h_ctx, wdown, qnorm_g, wuq, kvnorm_g, wuk, wuv, wo, ang, with_ctx_out):
    B, S, _ = h_lat.shape
    L = h_ctx.shape[1]
    scale = (B_NOPE + B_ROPE) ** -0.5

    def proj(h, ang_h):
        n = h.shape[1]
        d = h @ wdown
        cq = rmsnorm(d[..., :Q_LORA], qnorm_g)
        ckv = rmsnorm(d[..., Q_LORA:Q_LORA + KV_LORA], kvnorm_g)
        k_rope = d[..., Q_LORA + KV_LORA:][:, :, None, :]
        q = (cq @ wuq).reshape(B, n, B_HEADS, B_NOPE + B_ROPE)
        q_nope, q_rope = q[..., :B_NOPE], q[..., B_NOPE:]
        if ang_h is not None:
            q_rope = apply_rope(q_rope, ang_h)
            k_rope = apply_rope(k_rope, ang_h)
        k_nope = (ckv @ wuk).reshape(B, n, B_HEADS, B_NOPE)
        v = (ckv @ wuv).reshape(B, n, B_HEADS, B_V)
        q = jnp.concatenate([q_nope, q_rope], axis=-1) * scale
        k = jnp.concatenate([k_nope, jnp.broadcast_to(k_rope, (B, n, B_HEADS, B_ROPE))], axis=-1)
        return q, k, v

    q_lat, k_lat, v_lat = proj(h_lat, ang)
    q_ctx, k_ctx, v_ctx = proj(h_ctx, None)
    k_all = jnp.concatenate([k_ctx, k_lat], axis=1)
    v_all = jnp.concatenate([v_ctx, v_lat], axis=1)

    def block(i):
        qb = lax.dynamic_slice_in_dim(q_lat, i * BLOCK, BLOCK, axis=1)
        s = jnp.einsum('bqhd,bkhd->bhqk', qb, k_all).astype(jnp.float32)
        p = jax.nn.softmax(s, axis=-1)
        return jnp.einsum('bhqk,bkhd->bqhd', p.astype(v_all.dtype), v_all).reshape(B, BLOCK, B_HEADS * B_V)

    o_lat = lax.map(block, jnp.arange(S // BLOCK))
    o_lat = o_lat.transpose(1, 0, 2, 3).reshape(B, S, B_HEADS * B_V)
    out_lat = o_lat @ wo
    if not with_ctx_out:
        return out_lat, None
    s = jnp.einsum('bqhd,bkhd->bhqk', q_ctx, k_ctx).astype(jnp.float32)
    p = jax.nn.softmax(s, axis=-1)
    o_ctx = jnp.einsum('bhqk,bkhd->bqhd', p.astype(v_ctx.dtype), v_ctx).reshape(B, L, B_HEADS * B_V)
    return out_lat, o_ctx @ wo


def setup_inputs(seed: int = 0) -> dict:
    key = jax.random.key(seed)
    ks = jax.random.split(key, 24)
    f32 = jnp.float32

    def nrm(k, shape, fan_in):
        return jax.random.normal(k, shape, f32) * (fan_in ** -0.5)

    def gain(k, shape):
        return 1.0 + 0.02 * jax.random.normal(k, shape, f32)

    def bias(k, shape):
        return 0.02 * jax.random.normal(k, shape, f32)

    return {
        "x": jax.random.normal(ks[0], (BATCH, SEQ, D_MODEL), f32),
        "c": jax.random.normal(ks[1], (BATCH, D_MODEL), f32),
        "ctx": jax.random.normal(ks[2], (BATCH, CTX_LEN, D_MODEL), f32),
        "c_ctx": jax.random.normal(ks[3], (D_MODEL,), f32),
        "mod_w": nrm(ks[4], (DEPTH, D_MODEL, 6 * D_MODEL), D_MODEL),
        "mod_b": bias(ks[5], (DEPTH, 6 * D_MODEL)),
        "norm1_g": gain(ks[6], (DEPTH, D_MODEL)),
        "norm2_g": gain(ks[7], (DEPTH, D_MODEL)),
        "a_wqkv": nrm(ks[8], (N_A_LAYERS, D_MODEL, A_QW + 2 * A_KW), D_MODEL),
        "a_wo": nrm(ks[9], (N_A_LAYERS, A_QW, D_MODEL), A_QW),
        "a_sink": jax.random.normal(ks[10], (N_A_LAYERS, A_Q_HEADS), f32),
        "b_wdown": nrm(ks[11], (N_B_LAYERS, D_MODEL, Q_LORA + KV_LORA + B_ROPE), D_MODEL),
        "b_qnorm_g": gain(ks[12], (N_B_LAYERS, Q_LORA)),
        "b_wuq": nrm(ks[13], (N_B_LAYERS, Q_LORA, B_HEADS * (B_NOPE + B_ROPE)), Q_LORA),
        "b_kvnorm_g": gain(ks[14], (N_B_LAYERS, KV_LORA)),
        "b_wuk": nrm(ks[15], (N_B_LAYERS, KV_LORA, B_HEADS * B_NOPE), KV_LORA),
        "b_wuv": nrm(ks[16], (N_B_LAYERS, KV_LORA, B_HEADS * B_V), KV_LORA),
        "b_wo": nrm(ks[17], (N_B_LAYERS, B_HEADS * B_V, D_MODEL), B_HEADS * B_V),
        "f_win": nrm(ks[18], (DEPTH, D_MODEL, 2 * D_FF), D_MODEL),
        "f_conv_w": nrm(ks[19], (DEPTH, CONV_W, D_FF), CONV_W),
        "f_conv_b": bias(ks[20], (DEPTH, D_FF)),
        "f_wout": nrm(ks[21], (DEPTH, D_FF, D_MODEL), D_FF),
        "final_g": gain(ks[22], (D_MODEL,)),
    }


def reference(x, c, ctx, c_ctx, mod_w, mod_b, norm1_g, norm2_g, a_wqkv, a_wo, a_sink,
              b_wdown, b_qnorm_g, b_wuq, b_kvnorm_g, b_wuk, b_wuv, b_wo,
              f_win, f_conv_w, f_conv_b, f_wout, final_g):
    rows = x.shape[1] // GRID_W
    ang_a = axial_angles(rows, HEAD_DIM)
    ang_b = axial_angles(rows, B_ROPE)
    y = ctx
    silu_c = jax.nn.silu(c)
    silu_cc = jax.nn.silu(c_ctx)
    for i in range(DEPTH):
        with_ctx = i < DEPTH - 1
        mod_l = (silu_c @ mod_w[i] + mod_b[i])[:, None, :]
        mod_c = silu_cc @ mod_w[i] + mod_b[i]
        sh1, sc1, g1, sh2, sc2, g2 = jnp.split(mod_l, 6, axis=-1)
        csh1, csc1, cg1, csh2, csc2, cg2 = jnp.split(mod_c, 6, axis=-1)
        h_lat = modulate(rmsnorm(x, norm1_g[i]), sh1, sc1)
        h_ctx = modulate(rmsnorm(y, norm1_g[i]), csh1, csc1)
        j = i // N_MIXERS
        if i % N_MIXERS == 0:
            o_lat, o_ctx = window_gqa(h_lat, h_ctx, a_wqkv[j], a_wo[j], a_sink[j], ang_a, with_ctx)
        else:
            o_lat, o_ctx = mla(h_lat, h_ctx, b_wdown[j], b_qnorm_g[j], b_wuq[j], b_kvnorm_g[j],
                               b_wuk[j], b_wuv[j], b_wo[j], ang_b, with_ctx)
        x = x + g1 * o_lat
        h2 = modulate(rmsnorm(x, norm2_g[i]), sh2, sc2)
        x = x + g2 * conv_glu(h2, f_win[i], f_conv_w[i], f_conv_b[i], f_wout[i])
        if with_ctx:
            y = y + cg1 * o_ctx
            hc2 = modulate(rmsnorm(y, norm2_g[i]), csh2, csc2)
            y = y + cg2 * conv_glu(hc2, f_win[i], f_conv_w[i], f_conv_b[i], f_wout[i])
    return rmsnorm(x, final_g)
```

```cpp
#include <hip/hip_runtime.h>
#include <hip/hip_cooperative_groups.h>
#include <cstdio>
#include <cstdint>
namespace cg = cooperative_groups;

namespace pg8 {
#define PG8_LAS __attribute__((address_space(3)))
typedef unsigned short bf16_t;
typedef short bf16x8 __attribute__((ext_vector_type(8)));
typedef float f32x4 __attribute__((ext_vector_type(4)));
typedef unsigned u32x4 __attribute__((ext_vector_type(4)));
typedef unsigned u32x2 __attribute__((ext_vector_type(2)));
constexpr int BM = 256, BK = 64, HALF = 128, HTB = HALF * BK * 2  , STAGE_BYTES = 8 * HTB, NXCD = 8, WGM = 8;

__host__ __device__ __forceinline__ int lds_byte(int r, int c) { const int st = (r >> 4) * 2 + (c >> 5), rr = r & 15, cc = c & 31, ob = rr * 64 + cc * 2; return st * 1024 + (ob ^ (((ob >> 9) & 1) << 5)); }
__host__ __device__ __forceinline__ void stage_rc(int b, int& R, int& C) { const int st = b / 1024, sb = b % 1024, swz = sb ^ (((sb >> 9) & 1) << 5); R = (st >> 1) * 16 + swz / 64; C = (st & 1) * 32 + (swz % 64) / 2; }
__host__ __device__ __forceinline__ int perm32(int rho) { const int n = rho >> 4, i = rho & 15; return 8 * (i >> 2) + 4 * n + (i & 3); }

struct Unit { int pm, pn, koff, nt, ks; };
struct Gemm { const bf16_t* A; const bf16_t* Bt; int M, N, K; };

struct StaticOrder {
    int nM, nN, nwg, G, c, ntf, nsplit, nxt_units, ksz;
    __host__ __device__ void init(int M, int N, int K, int G_, int c_, int xrows = 0, int nsplit_ = 1) { nM = M / BM; nN = N / BM; nwg = nM * nN; G = G_; c = c_; ntf = K / BK;
        nsplit = nsplit_; nxt_units = (xrows / BM) * nN * nsplit_; ksz = K / nsplit_; }
    __host__ __device__ bool next(int i, Unit& u) const {
        const long L = (long)i * G + c; if (L >= nwg + nxt_units) return false;
        if (L >= nwg) { const int e = (int)L - nwg, ks = e % nsplit, tile = e / nsplit; u.pn = tile % nN; u.pm = nM + tile / nN; u.koff = ks * ksz; u.nt = ksz / BK; u.ks = ks; return true; }
        int wgid = (int)L; { const int q = nwg / NXCD, r = nwg % NXCD, xcd = wgid % NXCD, off = wgid / NXCD; wgid = (xcd < r ? xcd * (q + 1) : r * (q + 1) + (xcd - r) * q) + off; }
        const int nig = WGM * nN, gid = wgid / nig, fm = gid * WGM, gsz = (nM - fm) < WGM ? (nM - fm) : WGM;
        u.pm = fm + ((wgid % nig) % gsz); u.pn = (wgid % nig) / gsz; u.koff = 0; u.nt = ntf; u.ks = -1; return true;
    }
    __device__ __forceinline__ void a_ready(const Unit&) const {}
    __device__ __forceinline__ void done(const Unit&) const {}
};
__device__ __forceinline__ unsigned cvt_pk_bf16(float lo, float hi) { unsigned r; asm volatile("v_cvt_pk_bf16_f32 %0, %1, %2" : "=v"(r) : "v"(lo), "v"(hi)); return r; }
typedef __bf16 bf16x2_t __attribute__((ext_vector_type(2))); typedef float f32x2_t __attribute__((ext_vector_type(2)));
__device__ __forceinline__ unsigned cvt_pk_v(float lo, float hi) { return __builtin_bit_cast(unsigned, __builtin_convertvector((f32x2_t){lo, hi}, bf16x2_t)); }

template <class Epi, class Sched, bool ALIGN_EPI = false, bool SP2 = false>
__device__ __forceinline__ void gemm_phase(PG8_LAS unsigned char* lds, const Gemm g, const Sched& S, const Epi& E, const int tid) {
    const int wid = __builtin_amdgcn_readfirstlane(tid >> 6), lane = tid & 63, wr = wid >> 2, wc = wid & 3, fr = lane & 15, fq = lane >> 4;
    const int K = g.K;
    unsigned voffA[2], voffB[2];
#pragma unroll
    for (int i = 0; i < 2; ++i) { int R, C; stage_rc(tid * 16 + i * 8192, R, C); const int Rb = Epi::PERM ? ((R & ~31) + perm32(R & 31)) : R;
        voffA[i] = (unsigned)(R * K + C) * 2u; voffB[i] = (unsigned)(Rb * K + C) * 2u; }
    const size_t kstep = (size_t)(BK * 2);
    const size_t hstep = (size_t)HALF * K * 2;
    const size_t tstep = 2 * hstep;
    const unsigned ldsw = (unsigned)wid * 1024u;
    const int aoff = lds_byte(wr * 64 + fr, fq * 8), boff = lds_byte(wc * 32 + fr, fq * 8);
#define PG8_SA(b, h) (((b) * 2 + (h)) * HTB)
#define PG8_SB(b, h) ((4 + (b) * 2 + (h)) * HTB)
#define PG8_STAGE(bufoff, gbase, voff) do { _Pragma("unroll") for (int _i = 0; _i < 2; ++_i) \
        __builtin_amdgcn_global_load_lds((const unsigned*)((const char*)(gbase) + (voff)[_i]), (PG8_LAS unsigned*)(lds + (bufoff) + ldsw + _i * 8192), 16, 0, 0); } while (0)
#define PG8_LDA(dst, b, h) do { _Pragma("unroll") for (int m = 0; m < 4; ++m) _Pragma("unroll") for (int k = 0; k < 2; ++k) dst[m][k] = *(const PG8_LAS bf16x8*)(lds + PG8_SA(b, h) + aoff + m * 2048 + k * 1024); } while (0)
#define PG8_LDB(dst, b, h) do { _Pragma("unroll") for (int n = 0; n < 2; ++n) _Pragma("unroll") for (int k = 0; k < 2; ++k) dst[n][k] = *(const PG8_LAS bf16x8*)(lds + PG8_SB(b, h) + boff + n * 2048 + k * 1024); } while (0)
#define PG8_MMA(ai, bj, At, Bt) do { __builtin_amdgcn_s_setprio(1); _Pragma("unroll") for (int m = 0; m < 4; ++m) _Pragma("unroll") for (int n = 0; n < 2; ++n) _Pragma("unroll") for (int k = 0; k < 2; ++k) \
        acc[ai][bj][m][n] = __builtin_amdgcn_mfma_f32_16x16x32_bf16(Bt[n][k], At[m][k], acc[ai][bj][m][n], 0, 0, 0); __builtin_amdgcn_s_setprio(0); } while (0)
#define PG8_WAIT_V(n) asm volatile("s_waitcnt vmcnt(" #n ")" ::: "memory")
#define PG8_WAIT_L(n) asm volatile("s_waitcnt lgkmcnt(" #n ")" ::: "memory")
#define PG8_BAR __builtin_amdgcn_s_barrier()
#define PG8_SCHED __builtin_amdgcn_sched_barrier(0)
    Unit cur, nxt; int ui = 0;
    if (!S.next(0, cur)) return;
    f32x4 acc[2][2][4][2];
#pragma unroll
    for (int a = 0; a < 2; ++a)
#pragma unroll
        for (int b = 0; b < 2; ++b)
#pragma unroll
            for (int m = 0; m < 4; ++m)
#pragma unroll
                for (int n = 0; n < 2; ++n) acc[a][b][m][n] = (f32x4){0.f, 0.f, 0.f, 0.f};
    bf16x8 At[4][2], B0[2][2], B1[2][2];
    const char* cA = (const char*)g.A + (size_t)cur.pm * tstep + (size_t)cur.koff * 2; const char* cB = (const char*)g.Bt + (size_t)cur.pn * tstep + (size_t)cur.koff * 2;
    S.a_ready(cur);
    if constexpr (SP2) {
        PG8_STAGE(PG8_SB(0, 0), cB, voffB); PG8_STAGE(PG8_SB(0, 1), cB + hstep, voffB); PG8_STAGE(PG8_SA(0, 0), cA, voffA); PG8_STAGE(PG8_SA(0, 1), cA + hstep, voffA);
        if (wr == 1) PG8_BAR;
        PG8_WAIT_V(2); PG8_BAR;
        PG8_STAGE(PG8_SB(1, 0), cB + kstep, voffB); PG8_STAGE(PG8_SA(1, 0), cA + kstep, voffA); PG8_STAGE(PG8_SB(1, 1), cB + hstep + kstep, voffB);
        PG8_WAIT_V(6); PG8_BAR;
    } else {
        PG8_STAGE(PG8_SB(0, 0), cB, voffB); PG8_STAGE(PG8_SA(0, 0), cA, voffA); PG8_STAGE(PG8_SB(0, 1), cB + hstep, voffB); PG8_STAGE(PG8_SA(0, 1), cA + hstep, voffA);
        if (wr == 1) PG8_BAR;
        PG8_WAIT_V(4); PG8_BAR;
        PG8_STAGE(PG8_SB(1, 0), cB + kstep, voffB); PG8_STAGE(PG8_SA(1, 0), cA + kstep, voffA); PG8_STAGE(PG8_SB(1, 1), cB + hstep + kstep, voffB);
        PG8_WAIT_V(6); PG8_BAR;
    }
    for (;;) {
        const bool has_next = S.next(ui + 1, nxt);
        const char* nA = has_next ? (const char*)g.A + (size_t)nxt.pm * tstep + (size_t)nxt.koff * 2 : cA; const char* nB = has_next ? (const char*)g.Bt + (size_t)nxt.pn * tstep + (size_t)nxt.koff * 2 : cB;
        const int nt = cur.nt;
        for (int t = 0; t < nt; t += 2) {
            const bool last = (t == nt - 2);
            const char* a1 = cA + (size_t)(t + 1) * kstep;
            const char* a2 = last ? nA : cA + (size_t)(t + 2) * kstep; const char* b2 = last ? nB : cB + (size_t)(t + 2) * kstep;
            const char* a3 = a2 + kstep; const char* b3 = b2 + kstep;
            if (last && has_next) S.a_ready(nxt);
            if constexpr (SP2) {
            PG8_LDB(B0, 0, 0); PG8_LDB(B1, 0, 1); PG8_SCHED; PG8_LDA(At, 0, 0); PG8_STAGE(PG8_SA(1, 1), a1 + hstep, voffA);
            PG8_WAIT_V(8); PG8_WAIT_L(0); PG8_BAR; PG8_MMA(0, 0, At, B0); PG8_MMA(0, 1, At, B1); PG8_BAR; PG8_SCHED;
            PG8_LDA(At, 0, 1); PG8_STAGE(PG8_SB(0, 0), b2, voffB); PG8_STAGE(PG8_SB(0, 1), b2 + hstep, voffB); PG8_STAGE(PG8_SA(0, 0), a2, voffA);
            PG8_WAIT_V(8); PG8_WAIT_L(0); PG8_BAR; PG8_MMA(1, 0, At, B0); PG8_MMA(1, 1, At, B1); PG8_BAR; PG8_SCHED;
            PG8_LDB(B0, 1, 0); PG8_LDB(B1, 1, 1); PG8_SCHED; PG8_LDA(At, 1, 0); PG8_STAGE(PG8_SA(0, 1), a2 + hstep, voffA);
            PG8_WAIT_V(8); PG8_WAIT_L(0); PG8_BAR; PG8_MMA(0, 0, At, B0); PG8_MMA(0, 1, At, B1); PG8_BAR; PG8_SCHED;
            PG8_LDA(At, 1, 1); PG8_STAGE(PG8_SB(1, 0), b3, voffB); PG8_STAGE(PG8_SB(1, 1), b3 + hstep, voffB); PG8_STAGE(PG8_SA(1, 0), a3, voffA);
            PG8_WAIT_V(8); PG8_WAIT_L(0); PG8_BAR; PG8_MMA(1, 0, At, B0); PG8_MMA(1, 1, At, B1); PG8_BAR; PG8_SCHED;
            } else {
            PG8_LDB(B0, 0, 0); PG8_SCHED; PG8_LDA(At, 0, 0); PG8_STAGE(PG8_SA(1, 1), a1 + hstep, voffA);
            PG8_WAIT_L(8); PG8_BAR; PG8_WAIT_L(0); PG8_MMA(0, 0, At, B0); PG8_BAR; PG8_SCHED;
            PG8_LDB(B1, 0, 1); PG8_STAGE(PG8_SB(0, 0), b2, voffB);
            PG8_BAR; PG8_WAIT_L(0); PG8_MMA(0, 1, At, B1); PG8_BAR;
            PG8_LDA(At, 0, 1); PG8_STAGE(PG8_SA(0, 0), a2, voffA);
            PG8_BAR; PG8_WAIT_L(0); PG8_MMA(1, 0, At, B0); PG8_BAR; PG8_SCHED;
            PG8_STAGE(PG8_SB(0, 1), b2 + hstep, voffB);
            PG8_WAIT_V(6); PG8_BAR; PG8_MMA(1, 1, At, B1); PG8_BAR;
            PG8_LDB(B0, 1, 0); PG8_SCHED; PG8_LDA(At, 1, 0); PG8_STAGE(PG8_SA(0, 1), a2 + hstep, voffA);
            PG8_WAIT_L(8); PG8_BAR; PG8_WAIT_L(0); PG8_MMA(0, 0, At, B0); PG8_BAR; PG8_SCHED;
            PG8_LDB(B1, 1, 1); PG8_STAGE(PG8_SB(1, 0), b3, voffB);
            PG8_BAR; PG8_WAIT_L(0); PG8_MMA(0, 1, At, B1); PG8_BAR;
            PG8_LDA(At, 1, 1); PG8_STAGE(PG8_SA(1, 0), a3, voffA);
            PG8_BAR; PG8_WAIT_L(0); PG8_MMA(1, 0, At, B0); PG8_BAR; PG8_SCHED;
            PG8_STAGE(PG8_SB(1, 1), b3 + hstep, voffB);
            PG8_WAIT_V(6); PG8_BAR; PG8_MMA(1, 1, At, B1); PG8_BAR;
            }
        }
        if constexpr (ALIGN_EPI) { if (wr == 0) PG8_BAR; }
        if constexpr (!Epi::AFTER_DRAIN) { E(acc, cur, wr, wc, fr, fq); S.done(cur); }
        if (!has_next) break;
#pragma unroll
        for (int a = 0; a < 2; ++a)
#pragma unroll
            for (int b = 0; b < 2; ++b)
#pragma unroll
                for (int m = 0; m < 4; ++m)
#pragma unroll
                    for (int n = 0; n < 2; ++n) acc[a][b][m][n] = (f32x4){0.f, 0.f, 0.f, 0.f};
        cur = nxt; cA = nA; cB = nB; ++ui;
        if constexpr (ALIGN_EPI) { if (wr == 1) PG8_BAR; }
    }
    PG8_WAIT_V(0);
    if constexpr (!ALIGN_EPI) { if (wr == 0) PG8_BAR; }
    PG8_BAR;
    if constexpr (Epi::AFTER_DRAIN) { E.fused(acc, cur, wr, wc, fr, fq, lds, wid, lane); S.done(cur); }
#undef PG8_SA
#undef PG8_SB
#undef PG8_STAGE
#undef PG8_LDA
#undef PG8_LDB
#undef PG8_MMA
#undef PG8_WAIT_V
#undef PG8_WAIT_L
#undef PG8_BAR
#undef PG8_SCHED
}
}

using pg8::bf16_t; using pg8::bf16x8; using pg8::f32x4; using pg8::u32x4; using pg8::u32x2; using pg8::cvt_pk_bf16; using pg8::cvt_pk_v;
#define LAS __attribute__((address_space(3)))
constexpr int DM = 1024, NBATCH = 8, SEQ = 4096, CTXL = 256, DEPTH = 4;
constexpr int MLAT = NBATCH * SEQ, MCTX = NBATCH * CTXL, MTOT = MLAT + MCTX;
constexpr int KPB = CTXL + SEQ;
constexpr int DFF = 2816;
constexpr int NCHUNK = MTOT / 64;
constexpr float LOG2E = 1.4426950408889634f;
constexpr float C2A = 0.125f * LOG2E;
constexpr float C2B = 0.10206207261596577f * LOG2E;
constexpr float EPS = 1e-6f;
constexpr int NWAVES = 8, NTHR = 512;
constexpr int LDS_BYTES = 147456;

constexpr size_t MiB = 1u << 20;
constexpr size_t WS_Y = 0;
constexpr size_t WS_MOD = 8 * MiB;
constexpr size_t WS_CTL = 8 * MiB + 960 * 1024, CTL_BYTES = 16384;
constexpr size_t WS_ROPEA = 9 * MiB;
constexpr size_t WS_ROPEB = 10 * MiB;
constexpr size_t WS_W = 11 * MiB;
constexpr size_t W_AQKV = WS_W;
constexpr size_t W_AWO = W_AQKV + 6 * MiB;
constexpr size_t W_BDN = W_AWO + 4 * MiB;
constexpr size_t W_BUQ = W_BDN + 4 * MiB;
constexpr size_t W_BUKV = W_BUQ + 3 * MiB;
constexpr size_t W_BWO = W_BUKV + 2 * MiB;
constexpr size_t W_FIN = W_BWO + 4 * MiB;
constexpr size_t W_FOUT = W_FIN + 44 * MiB;
constexpr size_t WS_H = 100 * MiB;
constexpr size_t WS_R = 168 * MiB;
constexpr size_t RA_Q = WS_R, RA_K = WS_R + 68 * MiB, RA_VT = WS_R + 85 * MiB;
constexpr size_t RB_CQ = WS_R, RB_CKV = WS_R + 34 * MiB, RB_K = WS_R + 51 * MiB, RB_Q = WS_R + 153 * MiB, RB_VT = WS_R + 255 * MiB, RB_D = RB_Q;
constexpr size_t RF_U = WS_R, RF_EDGE = WS_R + 187 * MiB;
constexpr size_t PART_WO = WS_R, PART_FFN2 = WS_R + 224 * MiB;
constexpr int NS_WO = 2, NS_FFN2 = 2;
constexpr size_t XB_OFF = 64 * MiB;
constexpr size_t WS_END = WS_R + 323 * MiB;
static_assert(W_FOUT + 22 * MiB <= WS_H, "weights fit");
static_assert((size_t)NCHUNK * 2 * 3 * DFF * 4 <= 36 * MiB, "edge buffer");

struct Params { const float* in[23]; float* out; unsigned char* ws; int ph_lo, ph_hi; };
enum InIdx { I_X = 0, I_C, I_CTX, I_CCTX, I_MODW, I_MODB, I_N1G, I_N2G, I_AWQKV, I_AWO, I_ASINK, I_BWDOWN, I_BQNG, I_BWUQ, I_BKVNG, I_BWUK, I_BWUV, I_BWO, I_FWIN, I_FCW, I_FCB, I_FWOUT, I_FINALG };

__device__ __forceinline__ float shfl_f(float v, int src_lane) { return __builtin_bit_cast(float, __builtin_amdgcn_ds_bpermute(src_lane << 2, __builtin_bit_cast(int, v))); }
__device__ __forceinline__ float wave_sum(float v, int lane) {
#pragma unroll
    for (int o = 1; o < 64; o <<= 1) v += shfl_f(v, lane ^ o);
    return v;
}
__device__ __forceinline__ f32x4 bf4_to_f32(u32x2 w) { return (f32x4){__builtin_bit_cast(float, w.x << 16), __builtin_bit_cast(float, w.x & 0xffff0000u), __builtin_bit_cast(float, w.y << 16), __builtin_bit_cast(float, w.y & 0xffff0000u)}; }
__device__ __forceinline__ float silu_f(float a) { return a * __builtin_amdgcn_rcpf(1.0f + __expf(-a)); }

enum EpiKind { E_QKVA = 0, E_RES, E_D, E_QB, E_KVB, E_FFN1 };
struct Epi {
    static constexpr bool PERM = true, AFTER_DRAIN = false;
    int kind, layer, gidx;
    unsigned char* ws; float* X; const float* cw; const float* cb; float* part;
    __device__ __forceinline__ void operator()(const f32x4 (&acc)[2][2][4][2], const pg8::Unit& u, int wr, int wc, int fr, int fq) const {
        asm volatile("" : "+v"(fr), "+v"(fq));
        const int rowt = u.pm * 256;
        const bool lat = rowt < MLAT;
        const int b = lat ? (rowt >> 12) : ((rowt - MLAT) >> 8);
        const int p0 = lat ? (rowt & (SEQ - 1)) : (rowt - MLAT) & (CTXL - 1);
        const int kp_t = lat ? CTXL + p0 : p0;
        const int lane_r = wr * 64 + fr;
        const int colt = u.pn * 256 + wc * 32 + 8 * fq;
#define EPI_PK8(v0, v1, w) do { (w).x = cvt_pk_v((v0)[0], (v0)[1]); (w).y = cvt_pk_v((v0)[2], (v0)[3]); (w).z = cvt_pk_v((v1)[0], (v1)[1]); (w).w = cvt_pk_v((v1)[2], (v1)[3]); } while (0)
#define EPI_ROPE(v, cs) (f32x4){(v)[0] * (cs)[0] - (v)[1] * (cs)[1], (v)[0] * (cs)[1] + (v)[1] * (cs)[0], (v)[2] * (cs)[2] - (v)[3] * (cs)[3], (v)[2] * (cs)[3] + (v)[3] * (cs)[2]}
        if (kind == E_D) {
            bf16_t* dst = (bf16_t*)(ws + RB_D) + (size_t)rowt * DM;
#pragma unroll
            for (int ai = 0; ai < 2; ++ai)
#pragma unroll
                for (int m = 0; m < 4; ++m)
#pragma unroll
                    for (int bj = 0; bj < 2; ++bj) { u32x4 w; EPI_PK8(acc[ai][bj][m][0], acc[ai][bj][m][1], w); *(u32x4*)(dst + (size_t)(lane_r + ai * 128 + m * 16) * DM + colt + bj * 128) = w; }
        } else if (kind == E_RES && u.ks >= 0) {
            float* dst = part + ((size_t)u.ks * MCTX + (rowt - MLAT)) * DM;
#pragma unroll
            for (int ai = 0; ai < 2; ++ai)
#pragma unroll
                for (int m = 0; m < 4; ++m)
#pragma unroll
                    for (int bj = 0; bj < 2; ++bj)
#pragma unroll
                        for (int n = 0; n < 2; ++n) *(f32x4*)(dst + (size_t)(lane_r + ai * 128 + m * 16) * DM + colt + bj * 128 + n * 4) = acc[ai][bj][m][n];
        } else if (kind == E_RES && lat) {
            bf16_t* dst = (bf16_t*)((unsigned char*)X + XB_OFF) + (size_t)rowt * DM;
            const float* gate = (const float*)(ws + WS_MOD) + (size_t)(layer * 9 + b) * 6144 + gidx * DM;
#pragma unroll
            for (int bj = 0; bj < 2; ++bj) {
                const int col = colt + bj * 128; const f32x4 g0 = *(const f32x4*)(gate + col), g1 = *(const f32x4*)(gate + col + 4);
                u32x4 xw[2][4];
#pragma unroll
                for (int ai = 0; ai < 2; ++ai)
#pragma unroll
                    for (int m = 0; m < 4; ++m) xw[ai][m] = *(const u32x4*)(dst + (size_t)(lane_r + ai * 128 + m * 16) * DM + col);
#pragma unroll
                for (int ai = 0; ai < 2; ++ai)
#pragma unroll
                    for (int m = 0; m < 4; ++m) { bf16_t* p = dst + (size_t)(lane_r + ai * 128 + m * 16) * DM + col;
                        const f32x4 x0 = bf4_to_f32((u32x2){xw[ai][m].x, xw[ai][m].y}) + g0 * acc[ai][bj][m][0], x1 = bf4_to_f32((u32x2){xw[ai][m].z, xw[ai][m].w}) + g1 * acc[ai][bj][m][1];
                        u32x4 w; EPI_PK8(x0, x1, w); *(u32x4*)p = w; }
            }
        } else if (kind == E_RES) {
            float* dst = (float*)(ws + WS_Y) + (size_t)(rowt - MLAT) * DM;
            const float* gate = (const float*)(ws + WS_MOD) + (size_t)(layer * 9 + 8) * 6144 + gidx * DM;
#pragma unroll
            for (int bj = 0; bj < 2; ++bj)
#pragma unroll
                for (int n = 0; n < 2; ++n) {
                    const int col = colt + bj * 128 + n * 4; const f32x4 g4 = *(const f32x4*)(gate + col);
#pragma unroll
                    for (int ai = 0; ai < 2; ++ai)
#pragma unroll
                        for (int m = 0; m < 4; ++m) { float* p = dst + (size_t)(lane_r + ai * 128 + m * 16) * DM + col; f32x4 x4 = *(f32x4*)p; x4 = x4 + g4 * acc[ai][bj][m][n]; *(f32x4*)p = x4; }
                }
        } else if (kind == E_QKVA) {
            const float* rope = (const float*)(ws + WS_ROPEA);
            bf16_t* Q = (bf16_t*)(ws + RA_Q); bf16_t* Kd = (bf16_t*)(ws + RA_K); bf16_t* VT = (bf16_t*)(ws + RA_VT);
            const int sect = u.pn < 4 ? 0 : (u.pn == 4 ? 1 : 2);
#pragma unroll
            for (int ai = 0; ai < 2; ++ai)
#pragma unroll
                for (int m = 0; m < 4; ++m) {
                    const int rl = lane_r + ai * 128 + m * 16, row = rowt + rl, s = p0 + rl;
#pragma unroll
                    for (int bj = 0; bj < 2; ++bj) {
                        const int col = colt + bj * 128; f32x4 v0 = acc[ai][bj][m][0], v1 = acc[ai][bj][m][1];
                        if (sect < 2) {
                            if (lat) { const float* rp = rope + ((size_t)s * 32 + ((col & 63) >> 1)) * 2; const f32x4 c0 = *(const f32x4*)rp, c1 = *(const f32x4*)(rp + 4);
                                v0 = EPI_ROPE(v0, c0); v1 = EPI_ROPE(v1, c1); }
                            u32x4 w;
                            if (sect == 0) { v0 = v0 * C2A; v1 = v1 * C2A; EPI_PK8(v0, v1, w); *(u32x4*)(Q + (size_t)row * 1024 + col) = w; }
                            else { EPI_PK8(v0, v1, w); *(u32x4*)(Kd + (size_t)row * 256 + (col - 1024)) = w; }
                        } else {
#pragma unroll
                            for (int n = 0; n < 2; ++n) { const f32x4 v = n ? v1 : v0;
                                const int c2 = col + 4 * n - 1280, kvh = c2 >> 6, d = c2 & 63;
                                bf16_t* vp = VT + ((size_t)(b * 4 + kvh) * 64 + d) * KPB + kp_t + rl;
                                const unsigned w0 = cvt_pk_bf16(v[0], v[1]), w1 = cvt_pk_bf16(v[2], v[3]);
                                vp[0] = (bf16_t)(w0 & 0xffffu); vp[KPB] = (bf16_t)(w0 >> 16); vp[2 * KPB] = (bf16_t)(w1 & 0xffffu); vp[3 * KPB] = (bf16_t)(w1 >> 16); }
                        }
                    }
                }
        } else if (kind == E_QB) {
            const float* rope = (const float*)(ws + WS_ROPEB); bf16_t* Q = (bf16_t*)(ws + RB_Q);
#pragma unroll
            for (int ai = 0; ai < 2; ++ai)
#pragma unroll
                for (int m = 0; m < 4; ++m) {
                    const int rl = lane_r + ai * 128 + m * 16, row = rowt + rl, s = p0 + rl;
#pragma unroll
                    for (int bj = 0; bj < 2; ++bj) {
                        const int col = colt + bj * 128; f32x4 v0 = acc[ai][bj][m][0], v1 = acc[ai][bj][m][1];
                        const int d = col % 96;
                        if (lat && d >= 64) { const float* rp = rope + ((size_t)s * 16 + ((d - 64) >> 1)) * 2; const f32x4 c0 = *(const f32x4*)rp, c1 = *(const f32x4*)(rp + 4);
                            v0 = EPI_ROPE(v0, c0); v1 = EPI_ROPE(v1, c1); }
                        v0 = v0 * C2B; v1 = v1 * C2B; u32x4 w; EPI_PK8(v0, v1, w); *(u32x4*)(Q + (size_t)row * 1536 + col) = w;
                    }
                }
        } else if (kind == E_KVB) {
            bf16_t* Kd = (bf16_t*)(ws + RB_K); bf16_t* VT = (bf16_t*)(ws + RB_VT);
            const bool isv = u.pn >= 4;
#pragma unroll
            for (int ai = 0; ai < 2; ++ai)
#pragma unroll
                for (int m = 0; m < 4; ++m) {
                    const int rl = lane_r + ai * 128 + m * 16, row = rowt + rl;
#pragma unroll
                    for (int bj = 0; bj < 2; ++bj) {
                        const int col = (colt + bj * 128) & 1023, h = col >> 6, d = col & 63; const f32x4 v0 = acc[ai][bj][m][0], v1 = acc[ai][bj][m][1];
                        if (!isv) { u32x4 w; EPI_PK8(v0, v1, w); *(u32x4*)(Kd + (size_t)row * 1536 + h * 96 + d) = w; }
                        else {
#pragma unroll
                            for (int n = 0; n < 2; ++n) { const f32x4 v = n ? v1 : v0; bf16_t* vp = VT + ((size_t)(b * 16 + h) * 64 + d + 4 * n) * KPB + kp_t + rl;
                                const unsigned w0 = cvt_pk_bf16(v[0], v[1]), w1 = cvt_pk_bf16(v[2], v[3]);
                                vp[0] = (bf16_t)(w0 & 0xffffu); vp[KPB] = (bf16_t)(w0 >> 16); vp[2 * KPB] = (bf16_t)(w1 & 0xffffu); vp[3 * KPB] = (bf16_t)(w1 >> 16); }
                        }
                    }
                }
        } else {
            bf16_t* U = (bf16_t*)(ws + RF_U); float* EDGE = (float*)(ws + RF_EDGE);
#pragma unroll
            for (int ai = 0; ai < 2; ++ai) {
                const int chunk = u.pm * 4 + ai * 2 + wr;
                const int cseq = lat ? (chunk & 63) : ((chunk - MLAT / 64) & 3);
                const bool seq_first = cseq == 0, seq_last = lat ? (cseq == 63) : (cseq == 3);
                const int fb = u.pn * 128 + wc * 32 + 8 * fq;
                u32x2 uw0[4];
#pragma unroll
                for (int n = 0; n < 2; ++n) {
                    const int f0 = fb + 4 * n;
                    const f32x4 w0 = *(const f32x4*)(cw + f0), w1 = *(const f32x4*)(cw + DFF + f0), w2 = *(const f32x4*)(cw + 2 * DFF + f0), bb = *(const f32x4*)(cb + f0);
                    f32x4 pre[4];
#pragma unroll
                    for (int j = 0; j < 4; ++j) {
                        float t[4], up[4], dn[4];
#pragma unroll
                        for (int m = 0; m < 4; ++m) { t[m] = acc[ai][0][m][n][j];
                            up[m] = __builtin_bit_cast(float, __builtin_amdgcn_update_dpp(0, __builtin_bit_cast(int, t[m]), 0x121, 0xf, 0xf, false));
                            dn[m] = __builtin_bit_cast(float, __builtin_amdgcn_update_dpp(0, __builtin_bit_cast(int, t[m]), 0x12F, 0xf, 0xf, false)); }
#pragma unroll
                        for (int m = 0; m < 4; ++m) {
                            const float pv = (fr == 0) ? (m > 0 ? up[m > 0 ? m - 1 : 0] : 0.f) : up[m];
                            const float nx = (fr == 15) ? (m < 3 ? dn[m < 3 ? m + 1 : 3] : 0.f) : dn[m];
                            pre[m][j] = w0[j] * pv + w1[j] * t[m] + w2[j] * nx + bb[j];
                        }
                    }
#pragma unroll
                    for (int m = 0; m < 4; ++m) {
                        const bool top = (m == 0 && fr == 0), bot = (m == 3 && fr == 15);
                        const bool need_fix = (top && !seq_first) || (bot && !seq_last);
                        const f32x4 vv = acc[ai][1][m][n];
                        if (top || bot) {
                            float* e = EDGE + ((size_t)(chunk * 2 + (bot ? 1 : 0)) * 3) * DFF + f0;
                            *(f32x4*)e = acc[ai][0][m][n];
                            if (need_fix) { *(f32x4*)(e + DFF) = pre[m]; *(f32x4*)(e + 2 * DFF) = vv; }
                        }
                        u32x2 w; w.x = cvt_pk_bf16(silu_f(pre[m][0]) * vv[0], silu_f(pre[m][1]) * vv[1]); w.y = cvt_pk_bf16(silu_f(pre[m][2]) * vv[2], silu_f(pre[m][3]) * vv[3]);
                        if (n == 0) uw0[m] = w;
                        else if (!need_fix) { const int row = rowt + lane_r + ai * 128 + m * 16; *(u32x4*)(U + (size_t)row * DFF + fb) = (u32x4){uw0[m].x, uw0[m].y, w.x, w.y}; }
                    }
                }
            }
        }
#undef EPI_PK8
#undef EPI_ROPE
    }
};

#define TR_LOAD(t, item) do { const int nblk_ = N / 32, kb_ = (item) / nblk_, nb_ = (item) % nblk_; \
    _Pragma("unroll") for (int i = 0; i < 8; ++i) (t)[i] = *(const f32x4*)(W + (size_t)(64 * kb_ + 8 * i + (lane >> 3)) * N + 32 * nb_ + 4 * (lane & 7)); } while (0)
__device__ __forceinline__ void transpose_put(const f32x4 (&t)[8], int K, int N, bf16_t* WT, int mode, int row_off, LAS float* scr, int item, int lane) {
    const int nblk = N / 32, kb = item / nblk, nb = item % nblk, k0 = 64 * kb, n0 = 32 * nb;
#pragma unroll
    for (int i = 0; i < 8; ++i) { LAS float* d = scr + (8 * i + (lane >> 3)) * 33 + 4 * (lane & 7); d[0] = t[i][0]; d[1] = t[i][1]; d[2] = t[i][2]; d[3] = t[i][3]; }
    asm volatile("s_waitcnt lgkmcnt(0)" ::: "memory");
    int r0;
    if (mode == 0) r0 = row_off + n0;
    else { const int c = n0 < DFF ? n0 : n0 - DFF; r0 = 256 * (c >> 7) + (c & 127) + (n0 < DFF ? 0 : 128); }
    const int c = lane & 7;
#pragma unroll
    for (int j = 0; j < 4; ++j) { const int n = (lane >> 3) + 8 * j; const LAS float* s = scr + (8 * c) * 33 + n;
        u32x4 o; o.x = cvt_pk_bf16(s[0 * 33], s[1 * 33]); o.y = cvt_pk_bf16(s[2 * 33], s[3 * 33]); o.z = cvt_pk_bf16(s[4 * 33], s[5 * 33]); o.w = cvt_pk_bf16(s[6 * 33], s[7 * 33]);
        *(u32x4*)(WT + (size_t)(r0 + n) * K + k0 + 8 * c) = o; }
    asm volatile("s_waitcnt lgkmcnt(0)" ::: "memory");
}
__device__ __forceinline__ void transpose_matrix(const float* W, int K, int N, bf16_t* WT, int mode, int row_off, LAS float* scr, int gw, int NGW, int lane) {
    const int nitems = (K / 64) * (N / 32);
    int it = gw; if (it >= nitems) return;
    f32x4 ta[8], tb[8];
    TR_LOAD(ta, it);
    for (;;) {
        const int it1 = it + NGW; if (it1 < nitems) TR_LOAD(tb, it1);
        transpose_put(ta, K, N, WT, mode, row_off, scr, it, lane);
        if (it1 >= nitems) break;
        const int it2 = it1 + NGW; if (it2 < nitems) TR_LOAD(ta, it2);
        transpose_put(tb, K, N, WT, mode, row_off, scr, it1, lane);
        if (it2 >= nitems) break;
        it = it2;
    }
}
#undef TR_LOAD
__device__ __forceinline__ void prologue(const Params& P, unsigned char* ws, LAS unsigned char* lds, int tid, int lane, int wave) {
    const int G = gridDim.x, gw = blockIdx.x * NWAVES + wave, NGW = G * NWAVES;
    {
        LAS float* sv = (LAS float*)lds;
        LAS float* red = (LAS float*)(lds + 9 * 1024 * 4);
        bool loaded = false;
        for (int item = blockIdx.x; item < 4 * 48; item += G) {
            if (!loaded) {
                for (int e = tid; e < 9 * 1024; e += NTHR) { const float cv = e < 8192 ? P.in[I_C][e] : P.in[I_CCTX][e - 8192]; sv[e] = cv / (1.0f + __expf(-cv)); }
                loaded = true;
            }
            __syncthreads();
            const int li = item / 48, cb = item % 48, c4 = tid & 31, kg = tid >> 5;
            const float* W = P.in[I_MODW] + (size_t)li * 1024 * 6144 + (size_t)cb * 128 + 4 * c4;
            f32x4 a[9];
#pragma unroll
            for (int v = 0; v < 9; ++v) a[v] = (f32x4){0.f, 0.f, 0.f, 0.f};
#pragma unroll 8
            for (int k = kg * 64; k < kg * 64 + 64; ++k) { const f32x4 w = *(const f32x4*)(W + (size_t)k * 6144);
#pragma unroll
                for (int v = 0; v < 9; ++v) a[v] = a[v] + w * sv[v * 1024 + k]; }
#pragma unroll
            for (int v = 0; v < 9; ++v) *(LAS f32x4*)(red + (kg * 9 + v) * 128 + 4 * c4) = a[v];
            __syncthreads();
            for (int e = tid; e < 9 * 128; e += NTHR) { const int v = e >> 7, cc = e & 127; float sum = P.in[I_MODB][li * 6144 + cb * 128 + cc];
#pragma unroll
                for (int q = 0; q < 16; ++q) sum += red[(q * 9 + v) * 128 + cc];
                ((float*)(ws + WS_MOD))[(size_t)(li * 9 + v) * 6144 + cb * 128 + cc] = sum; }
        }
        __syncthreads();
    }
    {
        LAS float* scr = (LAS float*)(lds + wave * 16384);
        for (int d = 0; d < 22; ++d) {
            const float* src; bf16_t* dst; int K, N, mode = 0, row_off = 0;
            if (d < 2)       { src = P.in[I_AWQKV] + (size_t)d * 1024 * 1536;        dst = (bf16_t*)(ws + W_AQKV) + (size_t)d * 1536 * 1024;        K = 1024; N = 1536; }
            else if (d < 4)  { src = P.in[I_AWO] + (size_t)(d - 2) * 1024 * 1024;    dst = (bf16_t*)(ws + W_AWO) + (size_t)(d - 2) * 1024 * 1024;    K = 1024; N = 1024; }
            else if (d < 6)  { src = P.in[I_BWDOWN] + (size_t)(d - 4) * 1024 * 800;  dst = (bf16_t*)(ws + W_BDN) + (size_t)(d - 4) * 1024 * 1024;    K = 1024; N = 800; }
            else if (d < 8)  { src = P.in[I_BWUQ] + (size_t)(d - 6) * 512 * 1536;    dst = (bf16_t*)(ws + W_BUQ) + (size_t)(d - 6) * 1536 * 512;     K = 512; N = 1536; }
            else if (d < 10) { src = P.in[I_BWUK] + (size_t)(d - 8) * 256 * 1024;    dst = (bf16_t*)(ws + W_BUKV) + (size_t)(d - 8) * 2048 * 256;    K = 256; N = 1024; }
            else if (d < 12) { src = P.in[I_BWUV] + (size_t)(d - 10) * 256 * 1024;   dst = (bf16_t*)(ws + W_BUKV) + (size_t)(d - 10) * 2048 * 256;   K = 256; N = 1024; row_off = 1024; }
            else if (d < 14) { src = P.in[I_BWO] + (size_t)(d - 12) * 1024 * 1024;   dst = (bf16_t*)(ws + W_BWO) + (size_t)(d - 12) * 1024 * 1024;   K = 1024; N = 1024; }
            else if (d < 18) { src = P.in[I_FWIN] + (size_t)(d - 14) * 1024 * 5632;  dst = (bf16_t*)(ws + W_FIN) + (size_t)(d - 14) * 5632 * 1024;   K = 1024; N = 5632; mode = 1; }
            else             { src = P.in[I_FWOUT] + (size_t)(d - 18) * 2816 * 1024; dst = (bf16_t*)(ws + W_FOUT) + (size_t)(d - 18) * 1024 * 2816;  K = 2816; N = 1024; }
            transpose_matrix(src, K, N, dst, mode, row_off, scr, gw, NGW, lane);
        }
        const int gt = blockIdx.x * NTHR + tid, NGT = G * NTHR;
        for (int e = gt; e < 2 * 224 * 128; e += NGT) { const int li = e / (224 * 128), r = (e / 128) % 224, c = e & 127;
            *(u32x4*)((bf16_t*)(ws + W_BDN) + (size_t)li * 1024 * 1024 + (size_t)(800 + r) * 1024 + c * 8) = (u32x4){0u, 0u, 0u, 0u}; }
        for (int e = gt; e < SEQ * 32; e += NGT) { const int s = e >> 5, p = e & 31; const float pos = (float)(p < 16 ? (s >> 6) : (s & 63));
            const float inv = exp2f(-(float)(p & 15) * (13.287712379549449f / 16.0f)); const float ang = pos * inv;
            ((float*)(ws + WS_ROPEA))[(size_t)e * 2] = cosf(ang); ((float*)(ws + WS_ROPEA))[(size_t)e * 2 + 1] = sinf(ang); }
        for (int e = gt; e < SEQ * 16; e += NGT) { const int s = e >> 4, p = e & 15; const float pos = (float)(p < 8 ? (s >> 6) : (s & 63));
            const float inv = exp2f(-(float)(p & 7) * (13.287712379549449f / 8.0f)); const float ang = pos * inv;
            ((float*)(ws + WS_ROPEB))[(size_t)e * 2] = cosf(ang); ((float*)(ws + WS_ROPEB))[(size_t)e * 2 + 1] = sinf(ang); }
    }
}

__device__ __forceinline__ void norm_phase(const Params& P, unsigned char* ws, int layer, int which, int nrows, bool first, int lane, int wave, const float* pend_part, int pend_ns, const float* pend_gate) {
    const int gw = blockIdx.x * NWAVES + wave, NGW = gridDim.x * NWAVES;
    const float* g = (which == 0 ? P.in[I_N1G] : P.in[I_N2G]) + layer * DM;
    bf16_t* H = (bf16_t*)(ws + WS_H);
    for (int row = MLAT + gw; row < nrows; row += NGW) {
        float* wrow = (float*)(ws + WS_Y) + (size_t)(row - MLAT) * DM;
        const float* srow = first ? P.in[I_CTX] + (size_t)(row - MLAT) * DM : wrow;
        const float* mod = (const float*)(ws + WS_MOD) + (size_t)(layer * 9 + 8) * 6144 + which * 3 * DM;
        f32x4 v[4]; float ss = 0.f;
#pragma unroll
        for (int j = 0; j < 4; ++j) v[j] = *(const f32x4*)(srow + 4 * lane + 256 * j);
        if (pend_ns > 0) {
#pragma unroll
            for (int j = 0; j < 4; ++j) { const int col = 4 * lane + 256 * j; f32x4 a = (f32x4){0.f, 0.f, 0.f, 0.f};
                for (int ks = 0; ks < pend_ns; ++ks) a = a + *(const f32x4*)(pend_part + ((size_t)ks * MCTX + (row - MLAT)) * DM + col);
                v[j] = v[j] + *(const f32x4*)(pend_gate + col) * a; }
        }
#pragma unroll
        for (int j = 0; j < 4; ++j) ss += (v[j][0] * v[j][0] + v[j][1] * v[j][1]) + (v[j][2] * v[j][2] + v[j][3] * v[j][3]);
        const float rstd = rsqrtf(wave_sum(ss, lane) * (1.0f / DM) + EPS);
#pragma unroll
        for (int j = 0; j < 4; ++j) {
            const int col = 4 * lane + 256 * j;
            const f32x4 g4 = *(const f32x4*)(g + col), sh = *(const f32x4*)(mod + col), sc = *(const f32x4*)(mod + DM + col);
            const f32x4 h = (v[j] * rstd) * g4 * (sc + 1.0f) + sh;
            u32x2 w; w.x = cvt_pk_bf16(h[0], h[1]); w.y = cvt_pk_bf16(h[2], h[3]);
            *(u32x2*)(H + (size_t)row * DM + col) = w;
            if (first || pend_ns > 0) *(f32x4*)(wrow + col) = v[j];
        }
    }
    constexpr int NR = 2;
    bf16_t* XB = (bf16_t*)((unsigned char*)P.out + XB_OFF);
    for (int row0 = gw; row0 < MLAT; row0 += NR * NGW) {
        f32x4 v[NR][2][2]; float ss[NR];
#pragma unroll
        for (int r = 0; r < NR; ++r) { const int row = row0 + r * NGW; ss[r] = 0.f;
#pragma unroll
            for (int j = 0; j < 2; ++j) { const int col = 8 * lane + 512 * j;
                if (first) { v[r][j][0] = *(const f32x4*)(P.in[I_X] + (size_t)row * DM + col); v[r][j][1] = *(const f32x4*)(P.in[I_X] + (size_t)row * DM + col + 4); }
                else { const u32x4 w = *(const u32x4*)(XB + (size_t)row * DM + col); v[r][j][0] = bf4_to_f32((u32x2){w.x, w.y}); v[r][j][1] = bf4_to_f32((u32x2){w.z, w.w}); } } }
#pragma unroll
        for (int r = 0; r < NR; ++r)
#pragma unroll
            for (int j = 0; j < 2; ++j)
#pragma unroll
                for (int q = 0; q < 2; ++q) ss[r] += (v[r][j][q][0] * v[r][j][q][0] + v[r][j][q][1] * v[r][j][q][1]) + (v[r][j][q][2] * v[r][j][q][2] + v[r][j][q][3] * v[r][j][q][3]);
#pragma unroll
        for (int r = 0; r < NR; ++r) { const int row = row0 + r * NGW;
            const float rstd = rsqrtf(wave_sum(ss[r], lane) * (1.0f / DM) + EPS);
            const float* mod = (const float*)(ws + WS_MOD) + (size_t)(layer * 9 + (row >> 12)) * 6144 + which * 3 * DM;
#pragma unroll
            for (int j = 0; j < 2; ++j) { const int col = 8 * lane + 512 * j; u32x4 hw, xw;
#pragma unroll
                for (int q = 0; q < 2; ++q) {
                    const f32x4 g4 = *(const f32x4*)(g + col + 4 * q), sh = *(const f32x4*)(mod + col + 4 * q), sc = *(const f32x4*)(mod + DM + col + 4 * q);
                    const f32x4 h = (v[r][j][q] * rstd) * g4 * (sc + 1.0f) + sh;
                    if (q == 0) { hw.x = cvt_pk_bf16(h[0], h[1]); hw.y = cvt_pk_bf16(h[2], h[3]); xw.x = cvt_pk_bf16(v[r][j][q][0], v[r][j][q][1]); xw.y = cvt_pk_bf16(v[r][j][q][2], v[r][j][q][3]); }
                    else { hw.z = cvt_pk_bf16(h[0], h[1]); hw.w = cvt_pk_bf16(h[2], h[3]); xw.z = cvt_pk_bf16(v[r][j][q][0], v[r][j][q][1]); xw.w = cvt_pk_bf16(v[r][j][q][2], v[r][j][q][3]); }
                }
                *(u32x4*)(H + (size_t)row * DM + col) = hw;
                if (first) *(u32x4*)(XB + (size_t)row * DM + col) = xw;
            } }
    }
}

__device__ __forceinline__ void rownorm_phase(const Params& P, unsigned char* ws, int j, int lane, int wave) {
    const int gw = blockIdx.x * NWAVES + wave, NGW = gridDim.x * NWAVES;
    const bf16_t* D = (const bf16_t*)(ws + RB_D); bf16_t* CQ = (bf16_t*)(ws + RB_CQ); bf16_t* CKV = (bf16_t*)(ws + RB_CKV); bf16_t* Kd = (bf16_t*)(ws + RB_K);
    const float* qg = P.in[I_BQNG] + j * 512; const float* kg = P.in[I_BKVNG] + j * 256; const float* rope = (const float*)(ws + WS_ROPEB);
    for (int row = gw; row < MTOT; row += NGW) {
        const bool lat = row < MLAT; const int s = row & (SEQ - 1);
        const bf16_t* d = D + (size_t)row * DM;
        const u32x4 aw = *(const u32x4*)(d + 8 * lane); const u32x2 cw2 = *(const u32x2*)(d + 512 + 4 * lane);
        u32x2 kw = (u32x2){0u, 0u}; if (lane < 8) kw = *(const u32x2*)(d + 768 + 4 * lane);
        const f32x4 a0 = bf4_to_f32((u32x2){aw.x, aw.y}), a1 = bf4_to_f32((u32x2){aw.z, aw.w}), c0 = bf4_to_f32(cw2);
        f32x4 kr = bf4_to_f32(kw);
        const float sq = wave_sum((a0[0] * a0[0] + a0[1] * a0[1]) + (a0[2] * a0[2] + a0[3] * a0[3]) + (a1[0] * a1[0] + a1[1] * a1[1]) + (a1[2] * a1[2] + a1[3] * a1[3]), lane);
        const float sk = wave_sum((c0[0] * c0[0] + c0[1] * c0[1]) + (c0[2] * c0[2] + c0[3] * c0[3]), lane);
        const float rq = rsqrtf(sq * (1.0f / 512.0f) + EPS), rk = rsqrtf(sk * (1.0f / 256.0f) + EPS);
        { const f32x4 g0 = *(const f32x4*)(qg + 8 * lane), g1 = *(const f32x4*)(qg + 8 * lane + 4), g2 = *(const f32x4*)(kg + 4 * lane);
          const f32x4 h0 = a0 * rq * g0, h1 = a1 * rq * g1, h2 = c0 * rk * g2;
          u32x4 w4; w4.x = cvt_pk_bf16(h0[0], h0[1]); w4.y = cvt_pk_bf16(h0[2], h0[3]); w4.z = cvt_pk_bf16(h1[0], h1[1]); w4.w = cvt_pk_bf16(h1[2], h1[3]); *(u32x4*)(CQ + (size_t)row * 512 + 8 * lane) = w4;
          u32x2 w; w.x = cvt_pk_bf16(h2[0], h2[1]); w.y = cvt_pk_bf16(h2[2], h2[3]); *(u32x2*)(CKV + (size_t)row * 256 + 4 * lane) = w; }
        if (lat && lane < 8) { const f32x4 cs = *(const f32x4*)(rope + ((size_t)s * 16 + 2 * lane) * 2);
            kr = (f32x4){kr[0] * cs[0] - kr[1] * cs[1], kr[0] * cs[1] + kr[1] * cs[0], kr[2] * cs[2] - kr[3] * cs[3], kr[2] * cs[3] + kr[3] * cs[2]}; }
        const unsigned k0 = cvt_pk_bf16(kr[0], kr[1]), k1 = cvt_pk_bf16(kr[2], kr[3]);
        const unsigned b0 = (unsigned)__builtin_amdgcn_ds_bpermute((lane & 7) << 2, (int)k0), b1 = (unsigned)__builtin_amdgcn_ds_bpermute((lane & 7) << 2, (int)k1);
#pragma unroll
        for (int it = 0; it < 2; ++it) { const int h = (lane >> 3) + 8 * it; u32x2 w; w.x = b0; w.y = b1; *(u32x2*)(Kd + (size_t)row * 1536 + h * 96 + 64 + 4 * (lane & 7)) = w; }
    }
}

__device__ __forceinline__ void fixup_phase(const Params& P, unsigned char* ws, int layer, int nchunks, int lane, int wave) {
    const int gw = blockIdx.x * NWAVES + wave, NGW = gridDim.x * NWAVES;
    const float* E = (const float*)(ws + RF_EDGE); bf16_t* U = (bf16_t*)(ws + RF_U);
    const float* cw = P.in[I_FCW] + (size_t)layer * 3 * DFF;
    for (int it = gw; it < nchunks * 11; it += NGW) {
        const int c = it / 11, fb = it % 11, f = fb * 256 + 4 * lane;
        const bool start = c < MLAT / 64 ? ((c & 63) == 0) : (((c - MLAT / 64) & 3) == 0);
        if (start) continue;
        const float* eb = E + ((size_t)((c - 1) * 2 + 1) * 3) * DFF + f;
        const float* et = E + ((size_t)(c * 2) * 3) * DFF + f;
        const f32x4 ab = *(const f32x4*)eb, pb = *(const f32x4*)(eb + DFF), vb = *(const f32x4*)(eb + 2 * DFF);
        const f32x4 at = *(const f32x4*)et, pt = *(const f32x4*)(et + DFF), vt = *(const f32x4*)(et + 2 * DFF);
        const f32x4 w0 = *(const f32x4*)(cw + f), w2 = *(const f32x4*)(cw + 2 * DFF + f);
        const f32x4 xb = pb + w2 * at, xt = pt + w0 * ab;
        u32x2 w;
        w.x = cvt_pk_bf16(silu_f(xb[0]) * vb[0], silu_f(xb[1]) * vb[1]); w.y = cvt_pk_bf16(silu_f(xb[2]) * vb[2], silu_f(xb[3]) * vb[3]);
        *(u32x2*)(U + (size_t)(c * 64 - 1) * DFF + f) = w;
        w.x = cvt_pk_bf16(silu_f(xt[0]) * vt[0], silu_f(xt[1]) * vt[1]); w.y = cvt_pk_bf16(silu_f(xt[2]) * vt[2], silu_f(xt[3]) * vt[3]);
        *(u32x2*)(U + (size_t)(c * 64) * DFF + f) = w;
    }
}

constexpr float ATT_THR = 8.0f;
constexpr int AT_KB = 16384, AT_VB = 16384, AT_BUF = AT_KB + AT_VB;
template <int DQK, bool WIN, bool SAFE>
__device__ __forceinline__ bool attn_unit(const Params& P, unsigned char* ws, LAS unsigned char* lds, int layer_j, int u, int tid, int lane, int wave) {
    constexpr int NKS = DQK / 32, CPR = DQK / 8, NQ = 4;
    volatile LAS unsigned* badflag = (volatile LAS unsigned*)(lds + 4 * AT_BUF);
    const bf16_t* Q = (const bf16_t*)(ws + (WIN ? RA_Q : RB_Q)); const bf16_t* Kg = (const bf16_t*)(ws + (WIN ? RA_K : RB_K)); const bf16_t* VT = (const bf16_t*)(ws + (WIN ? RA_VT : RB_VT));
    bf16_t* O = (bf16_t*)(ws + WS_H);
    constexpr int QP = WIN ? 1024 : 1536, KP = WIN ? 256 : 1536, NHKV = WIN ? 4 : 16;
    const int fr = lane & 15, fq = lane >> 4;
    {
        const bool ctxq = u >= 1024;
        int b, hq, q0, nq;
        if (!ctxq) { q0 = (u & 7) * 512; hq = (u >> 3) & 15; b = u >> 7; nq = 512; } else { const int uc = u - 1024; hq = uc & 15; b = uc >> 4; q0 = 0; nq = 256; }
        const int hkv = WIN ? (hq >> 2) : hq;
        int s_lo = 0, s_hi = SEQ;
        if (WIN) { s_lo = q0 - 128 < 0 ? 0 : q0 - 128; s_hi = q0 + 512 + 128 > SEQ ? SEQ : q0 + 512 + 128; }
        const int nt = ctxq ? 4 : 4 + (s_hi - s_lo) / 64;
        const int qw = q0 + 64 * wave;
        const bool active = 64 * wave < nq;
        const size_t qrow0 = (ctxq ? (size_t)MLAT + b * CTXL : (size_t)b * SEQ) + qw;
        bf16x8 qf[NQ][NKS];
        if (active) {
#pragma unroll
            for (int qb = 0; qb < NQ; ++qb)
#pragma unroll
                for (int ks = 0; ks < NKS; ++ks) qf[qb][ks] = *(const bf16x8*)(Q + (qrow0 + 16 * qb + fr) * QP + hq * DQK + 32 * ks + 8 * fq);
        }
        bf16x8 ones8 = (bf16x8){0x3F80, 0x3F80, 0x3F80, 0x3F80, 0x3F80, 0x3F80, 0x3F80, 0x3F80}; asm volatile("" : "+v"(ones8));
        f32x4 o[4][NQ]; f32x4 negm[NQ]; f32x4 lacc[NQ];
        float m0 = 0.f, l0 = 0.f;
        if (WIN) { m0 = P.in[I_ASINK][layer_j * 16 + hq] * LOG2E; l0 = SAFE ? 1.f : __builtin_amdgcn_exp2f(m0); }
#pragma unroll
        for (int qb = 0; qb < NQ; ++qb) { negm[qb] = (f32x4){-m0, -m0, -m0, -m0}; lacc[qb] = (f32x4){l0, l0, l0, l0};
#pragma unroll
            for (int dv = 0; dv < 4; ++dv) o[dv][qb] = (f32x4){0.f, 0.f, 0.f, 0.f}; }
#define AT_KP(t) ((t) < 4 ? 64 * (t) : CTXL + s_lo + 64 * ((t) - 4))
#define AT_SWZ(r) ((((r) >> 3) & 3) << 2 | ((r) & 3))
#define AT_DMA(t) do { int ln_ = lane; asm volatile("" : "+v"(ln_)); const int kp0_ = AT_KP(t); const size_t kr0_ = kp0_ < CTXL ? (size_t)MLAT + b * CTXL + kp0_ : (size_t)b * SEQ + (kp0_ - CTXL); \
        LAS unsigned char* bb_ = lds + ((t) & 3) * AT_BUF + wave * 2048; \
        _Pragma("unroll") for (int i_ = 0; i_ < 2; ++i_) { const int p_ = wave * 2048 + i_ * 1024 + ln_ * 16, r_ = p_ >> 8, cs_ = (p_ >> 4) & 15; \
            const int ck_ = cs_ ^ AT_SWZ(r_), cv_ = cs_ ^ (r_ & 15); \
            if (ck_ < CPR) __builtin_amdgcn_global_load_lds((const unsigned*)(Kg + (kr0_ + r_) * KP + hkv * DQK + ck_ * 8), (LAS unsigned*)(bb_ + i_ * 1024), 16, 0, 0); \
            if (cv_ < 8) __builtin_amdgcn_global_load_lds((const unsigned*)(VT + ((size_t)(b * NHKV + hkv) * 64 + r_) * KPB + kp0_ + cv_ * 8), (LAS unsigned*)(bb_ + AT_KB + i_ * 1024), 16, 0, 0); } } while (0)
#define AT_BAR() do { asm volatile("s_waitcnt lgkmcnt(0)" ::: "memory"); __builtin_amdgcn_s_barrier(); asm volatile("" ::: "memory"); } while (0)
        asm volatile("s_waitcnt vmcnt(0)" ::: "memory");
        __syncthreads();
        AT_DMA(0); if (nt > 1) AT_DMA(1);
        if (tid == 0) badflag[0] = 0u;
        asm volatile("s_waitcnt vmcnt(0)" ::: "memory");
        AT_BAR();
        for (int t2 = 0; t2 < nt; t2 += 2) {
            if (t2 + 2 < nt) { AT_DMA(t2 + 2); AT_DMA(t2 + 3); }
          for (int t = t2; t < t2 + 2; ++t) {
            bool doit = active, need_mask = false; int k0 = 0;
            if (WIN && t >= 4) { k0 = s_lo + 64 * (t - 4);
                if (k0 > qw + 63 + 128 || k0 + 63 < qw - 128) doit = false;
                need_mask = !(k0 + 63 - qw <= 128 && qw + 63 - k0 <= 128); }
            if (doit) {
                int fr = lane & 15, fq = lane >> 4; asm volatile("" : "+v"(fr), "+v"(fq));
                const LAS unsigned char* kbase = lds + (t & 3) * AT_BUF; const LAS unsigned char* vbase = kbase + AT_KB;
#pragma unroll
                for (int g = 0; g < 2; ++g) {
                    f32x4 sc[2][NQ];
#pragma unroll
                    for (int kb = 0; kb < 2; ++kb)
#pragma unroll
                        for (int qb = 0; qb < NQ; ++qb) sc[kb][qb] = SAFE ? negm[qb] : (f32x4){0.f, 0.f, 0.f, 0.f};
                    bf16x8 kfa[NKS][2];
#pragma unroll
                    for (int ks = 0; ks < NKS; ++ks)
#pragma unroll
                        for (int kb = 0; kb < 2; ++kb) { const int r = 32 * g + 8 * (fr >> 2) + 4 * kb + (fr & 3);
                            kfa[ks][kb] = *(const LAS bf16x8*)(kbase + r * 256 + (((4 * ks + fq) ^ AT_SWZ(r)) << 4)); }
                    __builtin_amdgcn_sched_barrier(0);
#pragma unroll
                    for (int ks = 0; ks < NKS; ++ks)
#pragma unroll
                        for (int kb = 0; kb < 2; ++kb)
#pragma unroll
                            for (int qb = 0; qb < NQ; ++qb) sc[kb][qb] = __builtin_amdgcn_mfma_f32_16x16x32_bf16(kfa[ks][kb], qf[qb][ks], sc[kb][qb], 0, 0, 0);
                    if (WIN && need_mask) {
#pragma unroll
                        for (int qb = 0; qb < NQ; ++qb) { const int qpos = qw + 16 * qb + fr;
#pragma unroll
                            for (int kb = 0; kb < 2; ++kb)
#pragma unroll
                                for (int j = 0; j < 4; ++j) { const int dlt = qpos - (k0 + 32 * g + 8 * fq + 4 * kb + j); if (dlt > 128 || dlt < -128) sc[kb][qb][j] = -1e30f; } }
                    }
                    const bool first = !WIN && t == 0 && g == 0;
                    if (SAFE) {
                    float lmx[NQ], anymx = -1e30f;
#pragma unroll
                    for (int qb = 0; qb < NQ; ++qb) {
                        lmx[qb] = fmaxf(fmaxf(fmaxf(fmaxf(sc[0][qb][0], sc[0][qb][1]), sc[0][qb][2]), fmaxf(fmaxf(sc[0][qb][3], sc[1][qb][0]), sc[1][qb][1])), fmaxf(fmaxf(sc[1][qb][2], sc[1][qb][3]), -1e30f));
                        anymx = fmaxf(anymx, lmx[qb]);
                    }
                    if (first || __builtin_amdgcn_ballot_w64(anymx > ATT_THR) != 0ull) {
#pragma unroll
                        for (int qb = 0; qb < NQ; ++qb) {
                            float mx = lmx[qb]; mx = fmaxf(mx, shfl_f(mx, lane ^ 16)); mx = fmaxf(mx, shfl_f(mx, lane ^ 32));
                            const float delta = first ? mx : fmaxf(mx, 0.f);
                            const float alpha = first ? 1.f : __builtin_amdgcn_exp2f(-delta);
                            negm[qb] = negm[qb] - delta; sc[0][qb] = sc[0][qb] - delta; sc[1][qb] = sc[1][qb] - delta;
                            lacc[qb] = lacc[qb] * alpha;
#pragma unroll
                            for (int dv = 0; dv < 4; ++dv) o[dv][qb] = o[dv][qb] * alpha;
                        }
                    }
                    }
                    bf16x8 vfr[4];
#pragma unroll
                    for (int dv = 0; dv < 4; ++dv) vfr[dv] = *(const LAS bf16x8*)(vbase + (16 * dv + fr) * 256 + (((4 * g + fq) ^ fr) << 4));
                    __builtin_amdgcn_sched_barrier(0);
                    bf16x8 pf[NQ];
#pragma unroll
                    for (int qb = 0; qb < NQ; ++qb) {
                        float p[8];
#pragma unroll
                        for (int kb = 0; kb < 2; ++kb)
#pragma unroll
                            for (int j = 0; j < 4; ++j) p[4 * kb + j] = __builtin_amdgcn_exp2f(sc[kb][qb][j]);
                        u32x4 pk; pk.x = cvt_pk_v(p[0], p[1]); pk.y = cvt_pk_v(p[2], p[3]); pk.z = cvt_pk_v(p[4], p[5]); pk.w = cvt_pk_v(p[6], p[7]);
                        pf[qb] = __builtin_bit_cast(bf16x8, pk);
                        lacc[qb] = __builtin_amdgcn_mfma_f32_16x16x32_bf16(ones8, pf[qb], lacc[qb], 0, 0, 0);
                    }
#pragma unroll
                    for (int dv = 0; dv < 4; ++dv) {
#pragma unroll
                        for (int qb = 0; qb < NQ; ++qb) o[dv][qb] = __builtin_amdgcn_mfma_f32_16x16x32_bf16(vfr[dv], pf[qb], o[dv][qb], 0, 0, 0);
                    }
                }
            }
          }
            asm volatile("s_waitcnt vmcnt(0)" ::: "memory");
            AT_BAR();
        }
        bool wbad = false;
        if (active) {
#pragma unroll
            for (int qb = 0; qb < NQ; ++qb) {
                const float l = lacc[qb][0];
                if (!SAFE) wbad = wbad || !(l > 1e-30f && l < 1e30f);
                const float inv = 1.0f / l;
                bf16_t* op = O + (qrow0 + 16 * qb + fr) * DM + hq * 64 + 4 * fq;
#pragma unroll
                for (int dv = 0; dv < 4; ++dv) { const f32x4 v = o[dv][qb] * inv; u32x2 w; w.x = cvt_pk_v(v[0], v[1]); w.y = cvt_pk_v(v[2], v[3]); *(u32x2*)(op + 16 * dv) = w; }
            }
        }
#undef AT_DMA
#undef AT_BAR
#undef AT_KP
#undef AT_SWZ
        if (SAFE) return false;
        if (__builtin_amdgcn_ballot_w64(wbad) != 0ull && lane == 0) badflag[0] = 1u;
        __syncthreads();
        return badflag[0] != 0u;
    }
}
template <int DQK, bool WIN>
__device__ __forceinline__ void attn_phase(const Params& P, unsigned char* ws, LAS unsigned char* lds, int layer_j, bool with_ctx, int tid, int lane, int wave) {
    const int nunits = 1024 + (with_ctx ? 128 : 0);
    const int G_ = gridDim.x, bx_ = blockIdx.x, vcu = (G_ % 8 == 0) ? (bx_ % 8) * (G_ / 8) + bx_ / 8 : bx_;
    for (int u = vcu; u < nunits; u += G_) {
        if (attn_unit<DQK, WIN, false>(P, ws, lds, layer_j, u, tid, lane, wave)) (void)attn_unit<DQK, WIN, true>(P, ws, lds, layer_j, u, tid, lane, wave);
    }
    __syncthreads();
}

#define XB_TMO      128
#define XB_XCNT(j)  (256  + 64 * (j))
#define XB_XSUB(j)  (1280 + 64 * (j))
#define XB_XGEN(j)  (2304 + 64 * (j))
#define XB_TOP      3328
#define XB_TOPGEN   3392
#define XCD_BAR_WORDS 3456
#define XB_SPIN_CAP (1u << 18)

__device__ __forceinline__ unsigned xb_ld(unsigned* p)              { return __hip_atomic_load(p, __ATOMIC_RELAXED, __HIP_MEMORY_SCOPE_AGENT); }
__device__ __forceinline__ unsigned xb_add(unsigned* p, unsigned v) { return __hip_atomic_fetch_add(p, v, __ATOMIC_RELAXED, __HIP_MEMORY_SCOPE_AGENT); }
__device__ __forceinline__ unsigned xb_xcc_id() { return (unsigned)__builtin_amdgcn_s_getreg((3 << 11) | 20) & 0xFu; }
#define XB_SPIN(cond, bar) do { unsigned _sp = 0; while (cond) { __builtin_amdgcn_s_sleep(1); \
    if ((++_sp & 255u) == 0u) { if (xb_ld(&(bar)[XB_TMO])) break; if (_sp > XB_SPIN_CAP) { atomicAdd(&(bar)[XB_TMO], 1u); break; } } } } while (0)

struct XcdBarrier {
    unsigned* bar; unsigned x;
    volatile LAS unsigned* st;
};

__device__ __forceinline__ XcdBarrier xcd_barrier_post(unsigned* bar, volatile LAS unsigned* st) {
    XcdBarrier b; b.bar = bar; b.x = xb_xcc_id(); b.st = st;
    if (threadIdx.x == 0) (void)xb_add(&bar[XB_XCNT(b.x)], 1u);
    return b;
}
__device__ __forceinline__ void xcd_barrier_complete(unsigned* bar, unsigned x, unsigned& nloc, unsigned& nx) {
    const unsigned G = gridDim.x * gridDim.y * gridDim.z;
    unsigned sum, cnt, mine, sp = 0u;
    for (;;) {
        sum = 0u; cnt = 0u; mine = 0u;
#pragma unroll
        for (unsigned j = 0; j < 16; ++j) { const unsigned c = xb_ld(&bar[XB_XCNT(j)]); sum += c; cnt += (c > 0u) ? 1u : 0u; mine = (j == x) ? c : mine; }
        if (sum == G) break;
        __builtin_amdgcn_s_sleep(1);
        if ((++sp & 255u) == 0u) { if (xb_ld(&bar[XB_TMO])) break; if (sp > XB_SPIN_CAP) { atomicAdd(&bar[XB_TMO], 1u); break; } }
    }
    nloc = mine > 0u ? mine : 1u; nx = cnt > 0u ? cnt : 1u;
}

__device__ __forceinline__ void xcd_barrier(const XcdBarrier& b) {
    asm volatile("s_waitcnt vmcnt(0)" ::: "memory");
    __syncthreads();
    if (threadIdx.x == 0) {
        unsigned* bar = b.bar;
        __builtin_amdgcn_s_waitcnt(0);
        unsigned nloc = b.st[0], nx = b.st[1];
        if (nloc == 0u) { xcd_barrier_complete(bar, b.x, nloc, nx); b.st[0] = nloc; b.st[1] = nx; }
        const unsigned old = xb_add(&bar[XB_XSUB(b.x)], 1u);
        const unsigned gen = old / nloc;
        if (old + 1u == (gen + 1u) * nloc) {
            __builtin_amdgcn_fence(__ATOMIC_RELEASE, "agent");
            asm volatile("s_waitcnt vmcnt(0)" ::: "memory");
            const unsigned og = xb_add(&bar[XB_TOP], 1u);
            const unsigned tg = og / nx;
            if (og + 1u == (tg + 1u) * nx) xb_add(&bar[XB_TOPGEN], 1u);
            else XB_SPIN(xb_ld(&bar[XB_TOPGEN]) == tg, bar);
            __builtin_amdgcn_fence(__ATOMIC_ACQUIRE, "agent");
            xb_add(&bar[XB_XGEN(b.x)], 1u);
            asm volatile("s_waitcnt vmcnt(0)" ::: "memory");
        } else {
            XB_SPIN(xb_ld(&bar[XB_XGEN(b.x)]) == gen, bar);
            __builtin_amdgcn_fence(__ATOMIC_ACQUIRE, "agent");
            asm volatile("s_waitcnt vmcnt(0)" ::: "memory");
        }
    }
    __syncthreads();
}


__device__ __forceinline__ void final_norm(const Params& P, const XcdBarrier& xbar, int lane, int wave) {
    const int gw = blockIdx.x * NWAVES + wave, NGW = gridDim.x * NWAVES;
    const float* g = P.in[I_FINALG];
    const bf16_t* XB = (const bf16_t*)((unsigned char*)P.out + XB_OFF);
#define FN_LOAD(vv, row) do { _Pragma("unroll") for (int j = 0; j < 2; ++j) { const u32x4 w_ = *(const u32x4*)(XB + (size_t)(row) * DM + 8 * lane + 512 * j); vv[j][0] = bf4_to_f32((u32x2){w_.x, w_.y}); vv[j][1] = bf4_to_f32((u32x2){w_.z, w_.w}); } } while (0)
#define FN_STORE(vv, row) do { float ss_ = 0.f; _Pragma("unroll") for (int j = 0; j < 2; ++j) _Pragma("unroll") for (int q = 0; q < 2; ++q) ss_ += (vv[j][q][0] * vv[j][q][0] + vv[j][q][1] * vv[j][q][1]) + (vv[j][q][2] * vv[j][q][2] + vv[j][q][3] * vv[j][q][3]); \
        const float rstd_ = rsqrtf(wave_sum(ss_, lane) * (1.0f / DM) + EPS); \
        _Pragma("unroll") for (int j = 0; j < 2; ++j) _Pragma("unroll") for (int q = 0; q < 2; ++q) { const int col_ = 8 * lane + 512 * j + 4 * q; *(f32x4*)(P.out + (size_t)(row) * DM + col_) = (vv[j][q] * rstd_) * *(const f32x4*)(g + col_); } } while (0)
    f32x4 vc[8][2][2];
#pragma unroll
    for (int k = 0; k < 8; ++k) { const int row = 16384 + gw + k * NGW; if (row < MLAT) FN_LOAD(vc[k], row); }
    for (int row = gw; row < 16384; row += NGW) { f32x4 v[2][2]; FN_LOAD(v, row); FN_STORE(v, row); }
    xcd_barrier(xbar);
#pragma unroll
    for (int k = 0; k < 8; ++k) { const int row = 16384 + gw + k * NGW; if (row < MLAT) FN_STORE(vc[k], row); }
#undef FN_LOAD
#undef FN_STORE
}

#ifndef DBL_MASK
#define DBL_MASK 0
#endif
enum PhType { PH_PRO = 0, PH_NORM1, PH_NORM2, PH_G_QKVA, PH_ATT_A, PH_G_WOA, PH_G_D, PH_ROWNORM, PH_G_QB, PH_G_KVB, PH_ATT_B, PH_G_WOB, PH_G_FFN1, PH_FIXUP, PH_G_FFN2, PH_FINAL };
constexpr int NPH = 1 + 8 + 11 + 8 + 11 + 1;
__device__ __forceinline__ void phase_decode(int ph, int& type, int& layer, bool& nosync) {
    nosync = false; layer = 0;
    if (ph == 0) { type = PH_PRO; return; }
    if (ph == NPH - 1) { type = PH_FINAL; return; }
    int r = ph - 1; const int pair = r / 19; r -= pair * 19;
    if (r < 8) { layer = 2 * pair;
        type = r == 0 ? PH_NORM1 : r == 1 ? PH_G_QKVA : r == 2 ? PH_ATT_A : r == 3 ? PH_G_WOA : r == 4 ? PH_NORM2 : r == 5 ? PH_G_FFN1 : r == 6 ? PH_FIXUP : PH_G_FFN2;
    } else { r -= 8; layer = 2 * pair + 1;
        type = r == 0 ? PH_NORM1 : r == 1 ? PH_G_D : r == 2 ? PH_ROWNORM : r == 3 ? PH_G_QB : r == 4 ? PH_G_KVB : r == 5 ? PH_ATT_B : r == 6 ? PH_G_WOB : r == 7 ? PH_NORM2 : r == 8 ? PH_G_FFN1 : r == 9 ? PH_FIXUP : PH_G_FFN2;
        nosync = (r == 3);
    }
}

__global__ void __launch_bounds__(NTHR, 2) fwd_megakernel(Params P) {
    extern __shared__ __attribute__((aligned(16))) unsigned char lds_raw[];
    LAS unsigned char* lds = (LAS unsigned char*)lds_raw;
    cg::grid_group grid = cg::this_grid();
    { volatile LAS unsigned* misc = (volatile LAS unsigned*)(lds + 131072 + 512); if (threadIdx.x < 4) misc[threadIdx.x] = 0u; __syncthreads(); }
    const XcdBarrier xbar = xcd_barrier_post((unsigned*)(P.ws + WS_CTL), (volatile LAS unsigned*)(lds + 131072 + 512));
    for (int ph = P.ph_lo; ph < P.ph_hi; ++ph) {
        int type, layer; bool nosync; phase_decode(ph, type, layer, nosync);
        for (int rep = 0; rep < (((DBL_MASK >> type) & 1) ? 2 : 1); ++rep) {
        if (rep) xcd_barrier(xbar);
        int tid = threadIdx.x; asm volatile("" : "+v"(tid));
        size_t zoff = 0; asm volatile("" : "+s"(zoff)); unsigned char* ws = P.ws + zoff;
        const int lane = tid & 63, wave = __builtin_amdgcn_readfirstlane(tid >> 6);
        const bool with_ctx = layer < DEPTH - 1; const int j = layer >> 1;
        const int Mi = with_ctx ? MTOT : MLAT;
        if (type == PH_PRO) prologue(P, ws, lds, tid, lane, wave);
        else if (type == PH_NORM1) norm_phase(P, ws, layer, 0, MTOT, layer == 0, lane, wave, (const float*)(ws + PART_FFN2), layer > 0 ? NS_FFN2 : 0, (const float*)(ws + WS_MOD) + (size_t)((layer > 0 ? layer - 1 : 0) * 9 + 8) * 6144 + 5 * DM);
        else if (type == PH_NORM2) norm_phase(P, ws, layer, 1, Mi, false, lane, wave, (const float*)(ws + PART_WO), with_ctx ? NS_WO : 0, (const float*)(ws + WS_MOD) + (size_t)(layer * 9 + 8) * 6144 + 2 * DM);
        else if (type == PH_ROWNORM) rownorm_phase(P, ws, j, lane, wave);
        else if (type == PH_FIXUP) fixup_phase(P, ws, layer, Mi / 64, lane, wave);
        else if (type == PH_FINAL) final_norm(P, xbar, lane, wave);
#ifndef NO_ATTA
        else if (type == PH_ATT_A) attn_phase<64, true>(P, ws, lds, j, with_ctx, tid, lane, wave);
#endif
#ifndef NO_ATTB
        else if (type == PH_ATT_B) attn_phase<96, false>(P, ws, lds, j, with_ctx, tid, lane, wave);
#endif
        else {
            pg8::Gemm g; Epi E; E.ws = ws; E.X = P.out; E.layer = layer; E.gidx = 0; E.cw = nullptr; E.cb = nullptr; E.part = nullptr; E.kind = E_RES; int xrows = 0, nsplit = 1;
            const bf16_t* H = (const bf16_t*)(ws + WS_H);
            switch (type) {
            case PH_G_QKVA: g = pg8::Gemm{H, (const bf16_t*)(ws + W_AQKV) + (size_t)j * 1536 * 1024, MTOT, 1536, 1024}; E.kind = E_QKVA; break;
            case PH_G_WOA:  g = pg8::Gemm{H, (const bf16_t*)(ws + W_AWO) + (size_t)j * 1024 * 1024, MLAT, 1024, 1024}; E.kind = E_RES; E.gidx = 2; E.part = (float*)(ws + PART_WO); if (with_ctx) { xrows = MCTX; nsplit = NS_WO; } break;
            case PH_G_D:    g = pg8::Gemm{H, (const bf16_t*)(ws + W_BDN) + (size_t)j * 1024 * 1024, MTOT, 1024, 1024}; E.kind = E_D; break;
            case PH_G_QB:   g = pg8::Gemm{(const bf16_t*)(ws + RB_CQ), (const bf16_t*)(ws + W_BUQ) + (size_t)j * 1536 * 512, Mi, 1536, 512}; E.kind = E_QB; break;
            case PH_G_KVB:  g = pg8::Gemm{(const bf16_t*)(ws + RB_CKV), (const bf16_t*)(ws + W_BUKV) + (size_t)j * 2048 * 256, MTOT, 2048, 256}; E.kind = E_KVB; break;
            case PH_G_WOB:  g = pg8::Gemm{H, (const bf16_t*)(ws + W_BWO) + (size_t)j * 1024 * 1024, MLAT, 1024, 1024}; E.kind = E_RES; E.gidx = 2; E.part = (float*)(ws + PART_WO); if (with_ctx) { xrows = MCTX; nsplit = NS_WO; } break;
            case PH_G_FFN1: g = pg8::Gemm{H, (const bf16_t*)(ws + W_FIN) + (size_t)layer * 5632 * 1024, Mi, 5632, 1024}; E.kind = E_FFN1;
                            E.cw = P.in[I_FCW] + (size_t)layer * 3 * DFF; E.cb = P.in[I_FCB] + (size_t)layer * DFF; break;
            default:        g = pg8::Gemm{(const bf16_t*)(ws + RF_U), (const bf16_t*)(ws + W_FOUT) + (size_t)layer * 1024 * 2816, MLAT, 1024, 2816}; E.kind = E_RES; E.gidx = 5; E.part = (float*)(ws + PART_FFN2); if (with_ctx) { xrows = MCTX; nsplit = NS_FFN2; } break;
            }
            pg8::StaticOrder S; S.init(g.M, g.N, g.K, (int)gridDim.x, (int)blockIdx.x, xrows, nsplit);
            __syncthreads();
#ifndef NO_GEMM
            pg8::gemm_phase<Epi, pg8::StaticOrder, true, true>(lds, g, S, E, tid);
#endif
            __syncthreads();
        }
        }
        if (ph + 1 < P.ph_hi && !nosync) { if (P.ph_lo < 0) grid.sync(); else xcd_barrier(xbar); }
    }
}

extern "C" void kernel_launch(void* const* d_in, const int* in_sizes, int n_in, void* d_out, int out_size, void* d_ws, size_t ws_size, hipStream_t stream) {
    static int grid = 0;
    if (grid == 0) {
        if (n_in != 23 || ws_size < WS_END) { fprintf(stderr, "kernel_launch: unexpected n_in %d / ws_size %zu (need %zu)\n", n_in, ws_size, (size_t)WS_END); grid = -1; return; }
        int dev = 0, cus = 0, per_cu = 0;
        hipGetDevice(&dev); hipDeviceGetAttribute(&cus, hipDeviceAttributeMultiprocessorCount, dev);
        if (hipFuncSetAttribute((const void*)fwd_megakernel, hipFuncAttributeMaxDynamicSharedMemorySize, LDS_BYTES) != hipSuccess) { fprintf(stderr, "kernel_launch: hipFuncSetAttribute failed\n"); grid = -1; return; }
        if (hipOccupancyMaxActiveBlocksPerMultiprocessor(&per_cu, (const void*)fwd_megakernel, NTHR, LDS_BYTES) != hipSuccess || per_cu < 1) { fprintf(stderr, "kernel_launch: occupancy query says %d\n", per_cu); per_cu = 1; }
        (void)hipGetLastError();
        grid = cus * 1;
        if (grid <= 0) grid = 256;
    }
    if (grid < 0) return;
    Params p{};
    for (int i = 0; i < 23; ++i) p.in[i] = (const float*)d_in[i];
    p.out = (float*)d_out; p.ws = (unsigned char*)d_ws; p.ph_lo = 0; p.ph_hi = NPH;
    if (hipMemsetAsync((char*)d_ws + WS_CTL, 0, CTL_BYTES, stream) != hipSuccess) { fprintf(stderr, "kernel_launch: memset failed\n"); return; }
    void* args[] = {&p};
    hipError_t e = hipLaunchCooperativeKernel((const void*)fwd_megakernel, dim3(grid), dim3(NTHR), args, LDS_BYTES, stream);
    if (e != hipSuccess) fprintf(stderr, "cooperative launch failed: %s (grid %d)\n", hipGetErrorString(e), grid);
}
```

```cpp
#include <hip/hip_runtime.h>
#include <hip/hip_cooperative_groups.h>
#include <cstdio>
#include <cstdint>
namespace cg = cooperative_groups;

namespace pg8 {
#define PG8_LAS __attribute__((address_space(3)))
typedef unsigned short bf16_t;
typedef short bf16x8 __attribute__((ext_vector_type(8)));
typedef float f32x4 __attribute__((ext_vector_type(4)));
typedef unsigned u32x4 __attribute__((ext_vector_type(4)));
typedef unsigned u32x2 __attribute__((ext_vector_type(2)));
constexpr int BM = 256, BK = 64, HALF = 128, HTB = HALF * BK * 2  , STAGE_BYTES = 8 * HTB, NXCD = 8, WGM = 8;

__host__ __device__ __forceinline__ int lds_byte(int r, int c) { const int st = (r >> 4) * 2 + (c >> 5), rr = r & 15, cc = c & 31, ob = rr * 64 + cc * 2; return st * 1024 + (ob ^ (((ob >> 9) & 1) << 5)); }
__host__ __device__ __forceinline__ void stage_rc(int b, int& R, int& C) { const int st = b / 1024, sb = b % 1024, swz = sb ^ (((sb >> 9) & 1) << 5); R = (st >> 1) * 16 + swz / 64; C = (st & 1) * 32 + (swz % 64) / 2; }
__host__ __device__ __forceinline__ int perm32(int rho) { const int n = rho >> 4, i = rho & 15; return 8 * (i >> 2) + 4 * n + (i & 3); }

struct Unit { int pm, pn, koff, nt, ks; };
struct Gemm { const bf16_t* A; const bf16_t* Bt; int M, N, K; };

struct StaticOrder {
    int nM, nN, nwg, G, c, ntf, nsplit, nxt_units, ksz;
    __host__ __device__ void init(int M, int N, int K, int G_, int c_, int xrows = 0, int nsplit_ = 1) { nM = M / BM; nN = N / BM; nwg = nM * nN; G = G_; c = c_; ntf = K / BK;
        nsplit = nsplit_; nxt_units = (xrows / BM) * nN * nsplit_; ksz = K / nsplit_; }
    __host__ __device__ bool next(int i, Unit& u) const {
        const long L = (long)i * G + c; if (L >= nwg + nxt_units) return false;
        if (L >= nwg) { const int e = (int)L - nwg, ks = e % nsplit, tile = e / nsplit; u.pn = tile % nN; u.pm = nM + tile / nN; u.koff = ks * ksz; u.nt = ksz / BK; u.ks = ks; return true; }
        int wgid = (int)L; { const int q = nwg / NXCD, r = nwg % NXCD, xcd = wgid % NXCD, off = wgid / NXCD; wgid = (xcd < r ? xcd * (q + 1) : r * (q + 1) + (xcd - r) * q) + off; }
        const int nig = WGM * nN, gid = wgid / nig, fm = gid * WGM, gsz = (nM - fm) < WGM ? (nM - fm) : WGM;
        u.pm = fm + ((wgid % nig) % gsz); u.pn = (wgid % nig) / gsz; u.koff = 0; u.nt = ntf; u.ks = -1; return true;
    }
    __device__ __forceinline__ void a_ready(const Unit&) const {}
    __device__ __forceinline__ void done(const Unit&) const {}
};
__device__ __forceinline__ unsigned cvt_pk_bf16(float lo, float hi) { unsigned r; asm volatile("v_cvt_pk_bf16_f32 %0, %1, %2" : "=v"(r) : "v"(lo), "v"(hi)); return r; }
typedef __bf16 bf16x2_t __attribute__((ext_vector_type(2))); typedef float f32x2_t __attribute__((ext_vector_type(2)));
__device__ __forceinline__ unsigned cvt_pk_v(float lo, float hi) { return __builtin_bit_cast(unsigned, __builtin_convertvector((f32x2_t){lo, hi}, bf16x2_t)); }

template <class Epi, class Sched, bool ALIGN_EPI = false, bool SP2 = false>
__device__ __forceinline__ void gemm_phase(PG8_LAS unsigned char* lds, const Gemm g, const Sched& S, const Epi& E, const int tid) {
    const int wid = __builtin_amdgcn_readfirstlane(tid >> 6), lane = tid & 63, wr = wid >> 2, wc = wid & 3, fr = lane & 15, fq = lane >> 4;
    const int K = g.K;
    unsigned voffA[2], voffB[2];
#pragma unroll
    for (int i = 0; i < 2; ++i) { int R, C; stage_rc(tid * 16 + i * 8192, R, C); const int Rb = Epi::PERM ? ((R & ~31) + perm32(R & 31)) : R;
        voffA[i] = (unsigned)(R * K + C) * 2u; voffB[i] = (unsigned)(Rb * K + C) * 2u; }
    const size_t kstep = (size_t)(BK * 2);
    const size_t hstep = (size_t)HALF * K * 2;
    const size_t tstep = 2 * hstep;
    const unsigned ldsw = (unsigned)wid * 1024u;
    const int aoff = lds_byte(wr * 64 + fr, fq * 8), boff = lds_byte(wc * 32 + fr, fq * 8);
#define PG8_SA(b, h) (((b) * 2 + (h)) * HTB)
#define PG8_SB(b, h) ((4 + (b) * 2 + (h)) * HTB)
#define PG8_STAGE(bufoff, gbase, voff) do { _Pragma("unroll") for (int _i = 0; _i < 2; ++_i) \
        __builtin_amdgcn_global_load_lds((const unsigned*)((const char*)(gbase) + (voff)[_i]), (PG8_LAS unsigned*)(lds + (bufoff) + ldsw + _i * 8192), 16, 0, 0); } while (0)
#define PG8_LDA(dst, b, h) do { _Pragma("unroll") for (int m = 0; m < 4; ++m) _Pragma("unroll") for (int k = 0; k < 2; ++k) dst[m][k] = *(const PG8_LAS bf16x8*)(lds + PG8_SA(b, h) + aoff + m * 2048 + k * 1024); } while (0)
#define PG8_LDB(dst, b, h) do { _Pragma("unroll") for (int n = 0; n < 2; ++n) _Pragma("unroll") for (int k = 0; k < 2; ++k) dst[n][k] = *(const PG8_LAS bf16x8*)(lds + PG8_SB(b, h) + boff + n * 2048 + k * 1024); } while (0)
#define PG8_MMA(ai, bj, At, Bt) do { __builtin_amdgcn_s_setprio(1); _Pragma("unroll") for (int m = 0; m < 4; ++m) _Pragma("unroll") for (int n = 0; n < 2; ++n) _Pragma("unroll") for (int k = 0; k < 2; ++k) \
        acc[ai][bj][m][n] = __builtin_amdgcn_mfma_f32_16x16x32_bf16(Bt[n][k], At[m][k], acc[ai][bj][m][n], 0, 0, 0); __builtin_amdgcn_s_setprio(0); } while (0)
#define PG8_WAIT_V(n) asm volatile("s_waitcnt vmcnt(" #n ")" ::: "memory")
#define PG8_WAIT_L(n) asm volatile("s_waitcnt lgkmcnt(" #n ")" ::: "memory")
#define PG8_BAR __builtin_amdgcn_s_barrier()
#define PG8_SCHED __builtin_amdgcn_sched_barrier(0)
    Unit cur, nxt; int ui = 0;
    if (!S.next(0, cur)) return;
    f32x4 acc[2][2][4][2];
#pragma unroll
    for (int a = 0; a < 2; ++a)
#pragma unroll
        for (int b = 0; b < 2; ++b)
#pragma unroll
            for (int m = 0; m < 4; ++m)
#pragma unroll
                for (int n = 0; n < 2; ++n) acc[a][b][m][n] = (f32x4){0.f, 0.f, 0.f, 0.f};
    bf16x8 At[4][2], B0[2][2], B1[2][2];
    const char* cA = (const char*)g.A + (size_t)cur.pm * tstep + (size_t)cur.koff * 2; const char* cB = (const char*)g.Bt + (size_t)cur.pn * tstep + (size_t)cur.koff * 2;
    S.a_ready(cur);
    if constexpr (SP2) {
        PG8_STAGE(PG8_SB(0, 0), cB, voffB); PG8_STAGE(PG8_SB(0, 1), cB + hstep, voffB); PG8_STAGE(PG8_SA(0, 0), cA, voffA); PG8_STAGE(PG8_SA(0, 1), cA + hstep, voffA);
        if (wr == 1) PG8_BAR;
        PG8_WAIT_V(2); PG8_BAR;
        PG8_STAGE(PG8_SB(1, 0), cB + kstep, voffB); PG8_STAGE(PG8_SA(1, 0), cA + kstep, voffA); PG8_STAGE(PG8_SB(1, 1), cB + hstep + kstep, voffB);
        PG8_WAIT_V(6); PG8_BAR;
    } else {
        PG8_STAGE(PG8_SB(0, 0), cB, voffB); PG8_STAGE(PG8_SA(0, 0), cA, voffA); PG8_STAGE(PG8_SB(0, 1), cB + hstep, voffB); PG8_STAGE(PG8_SA(0, 1), cA + hstep, voffA);
        if (wr == 1) PG8_BAR;
        PG8_WAIT_V(4); PG8_BAR;
        PG8_STAGE(PG8_SB(1, 0), cB + kstep, voffB); PG8_STAGE(PG8_SA(1, 0), cA + kstep, voffA); PG8_STAGE(PG8_SB(1, 1), cB + hstep + kstep, voffB);
        PG8_WAIT_V(6); PG8_BAR;
    }
    for (;;) {
        const bool has_next = S.next(ui + 1, nxt);
        const char* nA = has_next ? (const char*)g.A + (size_t)nxt.pm * tstep + (size_t)nxt.koff * 2 : cA; const char* nB = has_next ? (const char*)g.Bt + (size_t)nxt.pn * tstep + (size_t)nxt.koff * 2 : cB;
        const int nt = cur.nt;
        for (int t = 0; t < nt; t += 2) {
            const bool last = (t == nt - 2);
            const char* a1 = cA + (size_t)(t + 1) * kstep;
            const char* a2 = last ? nA : cA + (size_t)(t + 2) * kstep; const char* b2 = last ? nB : cB + (size_t)(t + 2) * kstep;
            const char* a3 = a2 + kstep; const char* b3 = b2 + kstep;
            if (last && has_next) S.a_ready(nxt);
            if constexpr (SP2) {
            PG8_LDB(B0, 0, 0); PG8_LDB(B1, 0, 1); PG8_SCHED; PG8_LDA(At, 0, 0); PG8_STAGE(PG8_SA(1, 1), a1 + hstep, voffA);
            PG8_WAIT_V(8); PG8_WAIT_L(0); PG8_BAR; PG8_MMA(0, 0, At, B0); PG8_MMA(0, 1, At, B1); PG8_BAR; PG8_SCHED;
            PG8_LDA(At, 0, 1); PG8_STAGE(PG8_SB(0, 0), b2, voffB); PG8_STAGE(PG8_SB(0, 1), b2 + hstep, voffB); PG8_STAGE(PG8_SA(0, 0), a2, voffA);
            PG8_WAIT_V(8); PG8_WAIT_L(0); PG8_BAR; PG8_MMA(1, 0, At, B0); PG8_MMA(1, 1, At, B1); PG8_BAR; PG8_SCHED;
            PG8_LDB(B0, 1, 0); PG8_LDB(B1, 1, 1); PG8_SCHED; PG8_LDA(At, 1, 0); PG8_STAGE(PG8_SA(0, 1), a2 + hstep, voffA);
            PG8_WAIT_V(8); PG8_WAIT_L(0); PG8_BAR; PG8_MMA(0, 0, At, B0); PG8_MMA(0, 1, At, B1); PG8_BAR; PG8_SCHED;
            PG8_LDA(At, 1, 1); PG8_STAGE(PG8_SB(1, 0), b3, voffB); PG8_STAGE(PG8_SB(1, 1), b3 + hstep, voffB); PG8_STAGE(PG8_SA(1, 0), a3, voffA);
            PG8_WAIT_V(8); PG8_WAIT_L(0); PG8_BAR; PG8_MMA(1, 0, At, B0); PG8_MMA(1, 1, At, B1); PG8_BAR; PG8_SCHED;
            } else {
            PG8_LDB(B0, 0, 0); PG8_SCHED; PG8_LDA(At, 0, 0); PG8_STAGE(PG8_SA(1, 1), a1 + hstep, voffA);
            PG8_WAIT_L(8); PG8_BAR; PG8_WAIT_L(0); PG8_MMA(0, 0, At, B0); PG8_BAR; PG8_SCHED;
            PG8_LDB(B1, 0, 1); PG8_STAGE(PG8_SB(0, 0), b2, voffB);
            PG8_BAR; PG8_WAIT_L(0); PG8_MMA(0, 1, At, B1); PG8_BAR;
            PG8_LDA(At, 0, 1); PG8_STAGE(PG8_SA(0, 0), a2, voffA);
            PG8_BAR; PG8_WAIT_L(0); PG8_MMA(1, 0, At, B0); PG8_BAR; PG8_SCHED;
            PG8_STAGE(PG8_SB(0, 1), b2 + hstep, voffB);
            PG8_WAIT_V(6); PG8_BAR; PG8_MMA(1, 1, At, B1); PG8_BAR;
            PG8_LDB(B0, 1, 0); PG8_SCHED; PG8_LDA(At, 1, 0); PG8_STAGE(PG8_SA(0, 1), a2 + hstep, voffA);
            PG8_WAIT_L(8); PG8_BAR; PG8_WAIT_L(0); PG8_MMA(0, 0, At, B0); PG8_BAR; PG8_SCHED;
            PG8_LDB(B1, 1, 1); PG8_STAGE(PG8_SB(1, 0), b3, voffB);
            PG8_BAR; PG8_WAIT_L(0); PG8_MMA(0, 1, At, B1); PG8_BAR;
            PG8_LDA(At, 1, 1); PG8_STAGE(PG8_SA(1, 0), a3, voffA);
            PG8_BAR; PG8_WAIT_L(0); PG8_MMA(1, 0, At, B0); PG8_BAR; PG8_SCHED;
            PG8_STAGE(PG8_SB(1, 1), b3 + hstep, voffB);
            PG8_WAIT_V(6); PG8_BAR; PG8_MMA(1, 1, At, B1); PG8_BAR;
            }
        }
        if constexpr (ALIGN_EPI) { if (wr == 0) PG8_BAR; }
        if constexpr (!Epi::AFTER_DRAIN) { E(acc, cur, wr, wc, fr, fq); S.done(cur); }
        if (!has_next) break;
#pragma unroll
        for (int a = 0; a < 2; ++a)
#pragma unroll
            for (int b = 0; b < 2; ++b)
#pragma unroll
                for (int m = 0; m < 4; ++m)
#pragma unroll
                    for (int n = 0; n < 2; ++n) acc[a][b][m][n] = (f32x4){0.f, 0.f, 0.f, 0.f};
        cur = nxt; cA = nA; cB = nB; ++ui;
        if constexpr (ALIGN_EPI) { if (wr == 1) PG8_BAR; }
    }
    PG8_WAIT_V(0);
    if constexpr (!ALIGN_EPI) { if (wr == 0) PG8_BAR; }
    PG8_BAR;
    if constexpr (Epi::AFTER_DRAIN) { E.fused(acc, cur, wr, wc, fr, fq, lds, wid, lane); S.done(cur); }
#undef PG8_SA
#undef PG8_SB
#undef PG8_STAGE
#undef PG8_LDA
#undef PG8_LDB
#undef PG8_MMA
#undef PG8_WAIT_V
#undef PG8_WAIT_L
#undef PG8_BAR
#undef PG8_SCHED
}
}

using pg8::bf16_t; using pg8::bf16x8; using pg8::f32x4; using pg8::u32x4; using pg8::u32x2; using pg8::cvt_pk_bf16; using pg8::cvt_pk_v;
#define LAS __attribute__((address_space(3)))
constexpr int DM = 1024, NBATCH = 8, SEQ = 4096, CTXL = 256, DEPTH = 4;
constexpr int MLAT = NBATCH * SEQ, MCTX = NBATCH * CTXL, MTOT = MLAT + MCTX;
constexpr int KPB = CTXL + SEQ;
constexpr int DFF = 2816;
constexpr int NCHUNK = MTOT / 64;
constexpr float LOG2E = 1.4426950408889634f;
constexpr float C2A = 0.125f * LOG2E;
constexpr float C2B = 0.10206207261596577f * LOG2E;
constexpr float EPS = 1e-6f;
constexpr int NWAVES = 8, NTHR = 512;
constexpr int LDS_BYTES = 147456;

constexpr size_t MiB = 1u << 20;
constexpr size_t WS_Y = 0;
constexpr size_t WS_MOD = 8 * MiB;
constexpr size_t WS_CTL = 8 * MiB + 960 * 1024, CTL_BYTES = 16384;
constexpr size_t WS_ROPEA = 9 * MiB;
constexpr size_t WS_ROPEB = 10 * MiB;
constexpr size_t WS_W = 11 * MiB;
constexpr size_t W_AQKV = WS_W;
constexpr size_t W_AWO = W_AQKV + 6 * MiB;
constexpr size_t W_BDN = W_AWO + 4 * MiB;
constexpr size_t W_BUQ = W_BDN + 4 * MiB;
constexpr size_t W_BUKV = W_BUQ + 3 * MiB;
constexpr size_t W_BWO = W_BUKV + 2 * MiB;
constexpr size_t W_FIN = W_BWO + 4 * MiB;
constexpr size_t W_FOUT = W_FIN + 44 * MiB;
constexpr size_t WS_H = 100 * MiB;
constexpr size_t WS_R = 168 * MiB;
constexpr size_t RA_Q = WS_R, RA_K = WS_R + 68 * MiB, RA_VT = WS_R + 85 * MiB;
constexpr size_t RB_CQ = WS_R, RB_CKV = WS_R + 34 * MiB, RB_K = WS_R + 51 * MiB, RB_Q = WS_R + 153 * MiB, RB_VT = WS_R + 255 * MiB, RB_D = RB_Q;
constexpr size_t RF_U = WS_R, RF_EDGE = WS_R + 187 * MiB;
constexpr size_t PART_WO = WS_R, PART_FFN2 = WS_R + 224 * MiB;
constexpr int NS_WO = 4, NS_FFN2 = 2;
constexpr size_t XB_OFF = 64 * MiB;
constexpr size_t WS_END = WS_R + 323 * MiB;
static_assert(W_FOUT + 22 * MiB <= WS_H, "weights fit");
static_assert((size_t)NCHUNK * 2 * 3 * DFF * 4 <= 36 * MiB, "edge buffer");

struct Params { const float* in[23]; float* out; unsigned char* ws; int ph_lo, ph_hi; };
enum InIdx { I_X = 0, I_C, I_CTX, I_CCTX, I_MODW, I_MODB, I_N1G, I_N2G, I_AWQKV, I_AWO, I_ASINK, I_BWDOWN, I_BQNG, I_BWUQ, I_BKVNG, I_BWUK, I_BWUV, I_BWO, I_FWIN, I_FCW, I_FCB, I_FWOUT, I_FINALG };

__device__ __forceinline__ float shfl_f(float v, int src_lane) { return __builtin_bit_cast(float, __builtin_amdgcn_ds_bpermute(src_lane << 2, __builtin_bit_cast(int, v))); }
__device__ __forceinline__ float wave_sum(float v, int lane) {
#pragma unroll
    for (int o = 1; o < 64; o <<= 1) v += shfl_f(v, lane ^ o);
    return v;
}
__device__ __forceinline__ f32x4 bf4_to_f32(u32x2 w) { return (f32x4){__builtin_bit_cast(float, w.x << 16), __builtin_bit_cast(float, w.x & 0xffff0000u), __builtin_bit_cast(float, w.y << 16), __builtin_bit_cast(float, w.y & 0xffff0000u)}; }
__device__ __forceinline__ float silu_f(float a) { return a * __builtin_amdgcn_rcpf(1.0f + __expf(-a)); }

enum EpiKind { E_QKVA = 0, E_RES, E_D, E_QB, E_KVB, E_FFN1 };
struct Epi {
    static constexpr bool PERM = true, AFTER_DRAIN = false;
    int kind, layer, gidx;
    unsigned char* ws; float* X; const float* cw; const float* cb; float* part;
    __device__ __forceinline__ void operator()(const f32x4 (&acc)[2][2][4][2], const pg8::Unit& u, int wr, int wc, int fr, int fq) const {
        asm volatile("" : "+v"(fr), "+v"(fq));
        const int rowt = u.pm * 256;
        const bool lat = rowt < MLAT;
        const int b = lat ? (rowt >> 12) : ((rowt - MLAT) >> 8);
        const int p0 = lat ? (rowt & (SEQ - 1)) : (rowt - MLAT) & (CTXL - 1);
        const int kp_t = lat ? CTXL + p0 : p0;
        const int lane_r = wr * 64 + fr;
        const int colt = u.pn * 256 + wc * 32 + 8 * fq;
#define EPI_PK8(v0, v1, w) do { (w).x = cvt_pk_v((v0)[0], (v0)[1]); (w).y = cvt_pk_v((v0)[2], (v0)[3]); (w).z = cvt_pk_v((v1)[0], (v1)[1]); (w).w = cvt_pk_v((v1)[2], (v1)[3]); } while (0)
#define EPI_ROPE(v, cs) (f32x4){(v)[0] * (cs)[0] - (v)[1] * (cs)[1], (v)[0] * (cs)[1] + (v)[1] * (cs)[0], (v)[2] * (cs)[2] - (v)[3] * (cs)[3], (v)[2] * (cs)[3] + (v)[3] * (cs)[2]}
        if (kind == E_D) {
            bf16_t* dst = (bf16_t*)(ws + RB_D) + (size_t)rowt * DM;
#pragma unroll
            for (int ai = 0; ai < 2; ++ai)
#pragma unroll
                for (int m = 0; m < 4; ++m)
#pragma unroll
                    for (int bj = 0; bj < 2; ++bj) { u32x4 w; EPI_PK8(acc[ai][bj][m][0], acc[ai][bj][m][1], w); *(u32x4*)(dst + (size_t)(lane_r + ai * 128 + m * 16) * DM + colt + bj * 128) = w; }
        } else if (kind == E_RES && u.ks >= 0) {
            float* dst = part + ((size_t)u.ks * MCTX + (rowt - MLAT)) * DM;
#pragma unroll
            for (int ai = 0; ai < 2; ++ai)
#pragma unroll
                for (int m = 0; m < 4; ++m)
#pragma unroll
                    for (int bj = 0; bj < 2; ++bj)
#pragma unroll
                        for (int n = 0; n < 2; ++n) *(f32x4*)(dst + (size_t)(lane_r + ai * 128 + m * 16) * DM + colt + bj * 128 + n * 4) = acc[ai][bj][m][n];
        } else if (kind == E_RES && lat) {
            bf16_t* dst = (bf16_t*)((unsigned char*)X + XB_OFF) + (size_t)rowt * DM;
            const float* gate = (const float*)(ws + WS_MOD) + (size_t)(layer * 9 + b) * 6144 + gidx * DM;
#pragma unroll
            for (int bj = 0; bj < 2; ++bj) {
                const int col = colt + bj * 128; const f32x4 g0 = *(const f32x4*)(gate + col), g1 = *(const f32x4*)(gate + col + 4);
                u32x4 xw[2][4];
#pragma unroll
                for (int ai = 0; ai < 2; ++ai)
#pragma unroll
                    for (int m = 0; m < 4; ++m) xw[ai][m] = *(const u32x4*)(dst + (size_t)(lane_r + ai * 128 + m * 16) * DM + col);
#pragma unroll
                for (int ai = 0; ai < 2; ++ai)
#pragma unroll
                    for (int m = 0; m < 4; ++m) { bf16_t* p = dst + (size_t)(lane_r + ai * 128 + m * 16) * DM + col;
                        const f32x4 x0 = bf4_to_f32((u32x2){xw[ai][m].x, xw[ai][m].y}) + g0 * acc[ai][bj][m][0], x1 = bf4_to_f32((u32x2){xw[ai][m].z, xw[ai][m].w}) + g1 * acc[ai][bj][m][1];
                        u32x4 w; EPI_PK8(x0, x1, w); *(u32x4*)p = w; }
            }
        } else if (kind == E_RES) {
            float* dst = (float*)(ws + WS_Y) + (size_t)(rowt - MLAT) * DM;
            const float* gate = (const float*)(ws + WS_MOD) + (size_t)(layer * 9 + 8) * 6144 + gidx * DM;
#pragma unroll
            for (int bj = 0; bj < 2; ++bj)
#pragma unroll
                for (int n = 0; n < 2; ++n) {
                    const int col = colt + bj * 128 + n * 4; const f32x4 g4 = *(const f32x4*)(gate + col);
#pragma unroll
                    for (int ai = 0; ai < 2; ++ai)
#pragma unroll
                        for (int m = 0; m < 4; ++m) { float* p = dst + (size_t)(lane_r + ai * 128 + m * 16) * DM + col; f32x4 x4 = *(f32x4*)p; x4 = x4 + g4 * acc[ai][bj][m][n]; *(f32x4*)p = x4; }
                }
        } else if (kind == E_QKVA) {
            const float* rope = (const float*)(ws + WS_ROPEA);
            bf16_t* Q = (bf16_t*)(ws + RA_Q); bf16_t* Kd = (bf16_t*)(ws + RA_K); bf16_t* VT = (bf16_t*)(ws + RA_VT);
            const int sect = u.pn < 4 ? 0 : (u.pn == 4 ? 1 : 2);
#pragma unroll
            for (int ai = 0; ai < 2; ++ai)
#pragma unroll
                for (int m = 0; m < 4; ++m) {
                    const int rl = lane_r + ai * 128 + m * 16, row = rowt + rl, s = p0 + rl;
#pragma unroll
                    for (int bj = 0; bj < 2; ++bj) {
                        const int col = colt + bj * 128; f32x4 v0 = acc[ai][bj][m][0], v1 = acc[ai][bj][m][1];
                        if (sect < 2) {
                            if (lat) { const float* rp = rope + ((size_t)s * 32 + ((col & 63) >> 1)) * 2; const f32x4 c0 = *(const f32x4*)rp, c1 = *(const f32x4*)(rp + 4);
                                v0 = EPI_ROPE(v0, c0); v1 = EPI_ROPE(v1, c1); }
                            u32x4 w;
                            if (sect == 0) { v0 = v0 * C2A; v1 = v1 * C2A; EPI_PK8(v0, v1, w); *(u32x4*)(Q + (size_t)row * 1024 + col) = w; }
                            else { EPI_PK8(v0, v1, w); *(u32x4*)(Kd + (size_t)row * 256 + (col - 1024)) = w; }
                        } else {
#pragma unroll
                            for (int n = 0; n < 2; ++n) { const f32x4 v = n ? v1 : v0;
                                const int c2 = col + 4 * n - 1280, kvh = c2 >> 6, d = c2 & 63;
                                bf16_t* vp = VT + ((size_t)(b * 4 + kvh) * 64 + d) * KPB + kp_t + rl;
                                const unsigned w0 = cvt_pk_bf16(v[0], v[1]), w1 = cvt_pk_bf16(v[2], v[3]);
                                vp[0] = (bf16_t)(w0 & 0xffffu); vp[KPB] = (bf16_t)(w0 >> 16); vp[2 * KPB] = (bf16_t)(w1 & 0xffffu); vp[3 * KPB] = (bf16_t)(w1 >> 16); }
                        }
                    }
                }
        } else if (kind == E_QB) {
            const float* rope = (const float*)(ws + WS_ROPEB); bf16_t* Q = (bf16_t*)(ws + RB_Q);
#pragma unroll
            for (int ai = 0; ai < 2; ++ai)
#pragma unroll
                for (int m = 0; m < 4; ++m) {
                    const int rl = lane_r + ai * 128 + m * 16, row = rowt + rl, s = p0 + rl;
#pragma unroll
                    for (int bj = 0; bj < 2; ++bj) {
                        const int col = colt + bj * 128; f32x4 v0 = acc[ai][bj][m][0], v1 = acc[ai][bj][m][1];
                        const int d = col % 96;
                        if (lat && d >= 64) { const float* rp = rope + ((size_t)s * 16 + ((d - 64) >> 1)) * 2; const f32x4 c0 = *(const f32x4*)rp, c1 = *(const f32x4*)(rp + 4);
                            v0 = EPI_ROPE(v0, c0); v1 = EPI_ROPE(v1, c1); }
                        v0 = v0 * C2B; v1 = v1 * C2B; u32x4 w; EPI_PK8(v0, v1, w); *(u32x4*)(Q + (size_t)row * 1536 + col) = w;
                    }
                }
        } else if (kind == E_KVB) {
            bf16_t* Kd = (bf16_t*)(ws + RB_K); bf16_t* VT = (bf16_t*)(ws + RB_VT);
            const bool isv = u.pn >= 4;
#pragma unroll
            for (int ai = 0; ai < 2; ++ai)
#pragma unroll
                for (int m = 0; m < 4; ++m) {
                    const int rl = lane_r + ai * 128 + m * 16, row = rowt + rl;
#pragma unroll
                    for (int bj = 0; bj < 2; ++bj) {
                        const int col = (colt + bj * 128) & 1023, h = col >> 6, d = col & 63; const f32x4 v0 = acc[ai][bj][m][0], v1 = acc[ai][bj][m][1];
                        if (!isv) { u32x4 w; EPI_PK8(v0, v1, w); *(u32x4*)(Kd + (size_t)row * 1536 + h * 96 + d) = w; }
                        else {
#pragma unroll
                            for (int n = 0; n < 2; ++n) { const f32x4 v = n ? v1 : v0; bf16_t* vp = VT + ((size_t)(b * 16 + h) * 64 + d + 4 * n) * KPB + kp_t + rl;
                                const unsigned w0 = cvt_pk_bf16(v[0], v[1]), w1 = cvt_pk_bf16(v[2], v[3]);
                                vp[0] = (bf16_t)(w0 & 0xffffu); vp[KPB] = (bf16_t)(w0 >> 16); vp[2 * KPB] = (bf16_t)(w1 & 0xffffu); vp[3 * KPB] = (bf16_t)(w1 >> 16); }
                        }
                    }
                }
        } else {
            bf16_t* U = (bf16_t*)(ws + RF_U); float* EDGE = (float*)(ws + RF_EDGE);
#pragma unroll
            for (int ai = 0; ai < 2; ++ai) {
                const int chunk = u.pm * 4 + ai * 2 + wr;
                const int cseq = lat ? (chunk & 63) : ((chunk - MLAT / 64) & 3);
                const bool seq_first = cseq == 0, seq_last = lat ? (cseq == 63) : (cseq == 3);
                const int fb = u.pn * 128 + wc * 32 + 8 * fq;
                u32x2 uw0[4];
#pragma unroll
                for (int n = 0; n < 2; ++n) {
                    const int f0 = fb + 4 * n;
                    const f32x4 w0 = *(const f32x4*)(cw + f0), w1 = *(const f32x4*)(cw + DFF + f0), w2 = *(const f32x4*)(cw + 2 * DFF + f0), bb = *(const f32x4*)(cb + f0);
                    f32x4 pre[4];
#pragma unroll
                    for (int j = 0; j < 4; ++j) {
                        float t[4], up[4], dn[4];
#pragma unroll
                        for (int m = 0; m < 4; ++m) { t[m] = acc[ai][0][m][n][j];
                            up[m] = __builtin_bit_cast(float, __builtin_amdgcn_update_dpp(0, __builtin_bit_cast(int, t[m]), 0x121, 0xf, 0xf, false));
                            dn[m] = __builtin_bit_cast(float, __builtin_amdgcn_update_dpp(0, __builtin_bit_cast(int, t[m]), 0x12F, 0xf, 0xf, false)); }
#pragma unroll
                        for (int m = 0; m < 4; ++m) {
                            const float pv = (fr == 0) ? (m > 0 ? up[m > 0 ? m - 1 : 0] : 0.f) : up[m];
                            const float nx = (fr == 15) ? (m < 3 ? dn[m < 3 ? m + 1 : 3] : 0.f) : dn[m];
                            pre[m][j] = w0[j] * pv + w1[j] * t[m] + w2[j] * nx + bb[j];
                        }
                    }
#pragma unroll
                    for (int m = 0; m < 4; ++m) {
                        const bool top = (m == 0 && fr == 0), bot = (m == 3 && fr == 15);
                        const bool need_fix = (top && !seq_first) || (bot && !seq_last);
                        const f32x4 vv = acc[ai][1][m][n];
                        if (top || bot) {
                            float* e = EDGE + ((size_t)(chunk * 2 + (bot ? 1 : 0)) * 3) * DFF + f0;
                            *(f32x4*)e = acc[ai][0][m][n];
                            if (need_fix) { *(f32x4*)(e + DFF) = pre[m]; *(f32x4*)(e + 2 * DFF) = vv; }
                        }
                        u32x2 w; w.x = cvt_pk_bf16(silu_f(pre[m][0]) * vv[0], silu_f(pre[m][1]) * vv[1]); w.y = cvt_pk_bf16(silu_f(pre[m][2]) * vv[2], silu_f(pre[m][3]) * vv[3]);
                        if (n == 0) uw0[m] = w;
                        else if (!need_fix) { const int row = rowt + lane_r + ai * 128 + m * 16; *(u32x4*)(U + (size_t)row * DFF + fb) = (u32x4){uw0[m].x, uw0[m].y, w.x, w.y}; }
                    }
                }
            }
        }
#undef EPI_PK8
#undef EPI_ROPE
    }
};

#define TR_LOAD(t, item) do { const int nblk_ = N / 32, kb_ = (item) / nblk_, nb_ = (item) % nblk_; \
    _Pragma("unroll") for (int i = 0; i < 8; ++i) (t)[i] = *(const f32x4*)(W + (size_t)(64 * kb_ + 8 * i + (lane >> 3)) * N + 32 * nb_ + 4 * (lane & 7)); } while (0)
__device__ __forceinline__ void transpose_put(const f32x4 (&t)[8], int K, int N, bf16_t* WT, int mode, int row_off, LAS float* scr, int item, int lane) {
    const int nblk = N / 32, kb = item / nblk, nb = item % nblk, k0 = 64 * kb, n0 = 32 * nb;
#pragma unroll
    for (int i = 0; i < 8; ++i) { LAS float* d = scr + (8 * i + (lane >> 3)) * 33 + 4 * (lane & 7); d[0] = t[i][0]; d[1] = t[i][1]; d[2] = t[i][2]; d[3] = t[i][3]; }
    asm volatile("s_waitcnt lgkmcnt(0)" ::: "memory");
    int r0;
    if (mode == 0) r0 = row_off + n0;
    else { const int c = n0 < DFF ? n0 : n0 - DFF; r0 = 256 * (c >> 7) + (c & 127) + (n0 < DFF ? 0 : 128); }
    const int c = lane & 7;
#pragma unroll
    for (int j = 0; j < 4; ++j) { const int n = (lane >> 3) + 8 * j; const LAS float* s = scr + (8 * c) * 33 + n;
        u32x4 o; o.x = cvt_pk_bf16(s[0 * 33], s[1 * 33]); o.y = cvt_pk_bf16(s[2 * 33], s[3 * 33]); o.z = cvt_pk_bf16(s[4 * 33], s[5 * 33]); o.w = cvt_pk_bf16(s[6 * 33], s[7 * 33]);
        *(u32x4*)(WT + (size_t)(r0 + n) * K + k0 + 8 * c) = o; }
    asm volatile("s_waitcnt lgkmcnt(0)" ::: "memory");
}
__device__ __forceinline__ void transpose_matrix(const float* W, int K, int N, bf16_t* WT, int mode, int row_off, LAS float* scr, int gw, int NGW, int lane) {
    const int nitems = (K / 64) * (N / 32);
    int it = gw; if (it >= nitems) return;
    f32x4 ta[8], tb[8];
    TR_LOAD(ta, it);
    for (;;) {
        const int it1 = it + NGW; if (it1 < nitems) TR_LOAD(tb, it1);
        transpose_put(ta, K, N, WT, mode, row_off, scr, it, lane);
        if (it1 >= nitems) break;
        const int it2 = it1 + NGW; if (it2 < nitems) TR_LOAD(ta, it2);
        transpose_put(tb, K, N, WT, mode, row_off, scr, it1, lane);
        if (it2 >= nitems) break;
        it = it2;
    }
}
#undef TR_LOAD
__device__ __forceinline__ void prologue(const Params& P, unsigned char* ws, LAS unsigned char* lds, int tid, int lane, int wave) {
    const int G = gridDim.x, gw = blockIdx.x * NWAVES + wave, NGW = G * NWAVES;
    {
        LAS float* sv = (LAS float*)lds;
        LAS float* red = (LAS float*)(lds + 9 * 1024 * 4);
        bool loaded = false;
        for (int item = blockIdx.x; item < 4 * 48; item += G) {
            if (!loaded) {
                for (int e = tid; e < 9 * 1024; e += NTHR) { const float cv = e < 8192 ? P.in[I_C][e] : P.in[I_CCTX][e - 8192]; sv[e] = cv / (1.0f + __expf(-cv)); }
                loaded = true;
            }
            __syncthreads();
            const int li = item / 48, cb = item % 48, c4 = tid & 31, kg = tid >> 5;
            const float* W = P.in[I_MODW] + (size_t)li * 1024 * 6144 + (size_t)cb * 128 + 4 * c4;
            f32x4 a[9];
#pragma unroll
            for (int v = 0; v < 9; ++v) a[v] = (f32x4){0.f, 0.f, 0.f, 0.f};
#pragma unroll 8
            for (int k = kg * 64; k < kg * 64 + 64; ++k) { const f32x4 w = *(const f32x4*)(W + (size_t)k * 6144);
#pragma unroll
                for (int v = 0; v < 9; ++v) a[v] = a[v] + w * sv[v * 1024 + k]; }
#pragma unroll
            for (int v = 0; v < 9; ++v) *(LAS f32x4*)(red + (kg * 9 + v) * 128 + 4 * c4) = a[v];
            __syncthreads();
            for (int e = tid; e < 9 * 128; e += NTHR) { const int v = e >> 7, cc = e & 127; float sum = P.in[I_MODB][li * 6144 + cb * 128 + cc];
#pragma unroll
                for (int q = 0; q < 16; ++q) sum += red[(q * 9 + v) * 128 + cc];
                ((float*)(ws + WS_MOD))[(size_t)(li * 9 + v) * 6144 + cb * 128 + cc] = sum; }
        }
        __syncthreads();
    }
    {
        LAS float* scr = (LAS float*)(lds + wave * 16384);
        for (int d = 0; d < 22; ++d) {
            const float* src; bf16_t* dst; int K, N, mode = 0, row_off = 0;
            if (d < 2)       { src = P.in[I_AWQKV] + (size_t)d * 1024 * 1536;        dst = (bf16_t*)(ws + W_AQKV) + (size_t)d * 1536 * 1024;        K = 1024; N = 1536; }
            else if (d < 4)  { src = P.in[I_AWO] + (size_t)(d - 2) * 1024 * 1024;    dst = (bf16_t*)(ws + W_AWO) + (size_t)(d - 2) * 1024 * 1024;    K = 1024; N = 1024; }
            else if (d < 6)  { src = P.in[I_BWDOWN] + (size_t)(d - 4) * 1024 * 800;  dst = (bf16_t*)(ws + W_BDN) + (size_t)(d - 4) * 1024 * 1024;    K = 1024; N = 800; }
            else if (d < 8)  { src = P.in[I_BWUQ] + (size_t)(d - 6) * 512 * 1536;    dst = (bf16_t*)(ws + W_BUQ) + (size_t)(d - 6) * 1536 * 512;     K = 512; N = 1536; }
            else if (d < 10) { src = P.in[I_BWUK] + (size_t)(d - 8) * 256 * 1024;    dst = (bf16_t*)(ws + W_BUKV) + (size_t)(d - 8) * 2048 * 256;    K = 256; N = 1024; }
            else if (d < 12) { src = P.in[I_BWUV] + (size_t)(d - 10) * 256 * 1024;   dst = (bf16_t*)(ws + W_BUKV) + (size_t)(d - 10) * 2048 * 256;   K = 256; N = 1024; row_off = 1024; }
            else if (d < 14) { src = P.in[I_BWO] + (size_t)(d - 12) * 1024 * 1024;   dst = (bf16_t*)(ws + W_BWO) + (size_t)(d - 12) * 1024 * 1024;   K = 1024; N = 1024; }
            else if (d < 18) { src = P.in[I_FWIN] + (size_t)(d - 14) * 1024 * 5632;  dst = (bf16_t*)(ws + W_FIN) + (size_t)(d - 14) * 5632 * 1024;   K = 1024; N = 5632; mode = 1; }
            else             { src = P.in[I_FWOUT] + (size_t)(d - 18) * 2816 * 1024; dst = (bf16_t*)(ws + W_FOUT) + (size_t)(d - 18) * 1024 * 2816;  K = 2816; N = 1024; }
            transpose_matrix(src, K, N, dst, mode, row_off, scr, gw, NGW, lane);
        }
        const int gt = blockIdx.x * NTHR + tid, NGT = G * NTHR;
        for (int e = gt; e < 2 * 224 * 128; e += NGT) { const int li = e / (224 * 128), r = (e / 128) % 224, c = e & 127;
            *(u32x4*)((bf16_t*)(ws + W_BDN) + (size_t)li * 1024 * 1024 + (size_t)(800 + r) * 1024 + c * 8) = (u32x4){0u, 0u, 0u, 0u}; }
        for (int e = gt; e < SEQ * 32; e += NGT) { const int s = e >> 5, p = e & 31; const float pos = (float)(p < 16 ? (s >> 6) : (s & 63));
            const float inv = exp2f(-(float)(p & 15) * (13.287712379549449f / 16.0f)); const float ang = pos * inv;
            ((float*)(ws + WS_ROPEA))[(size_t)e * 2] = cosf(ang); ((float*)(ws + WS_ROPEA))[(size_t)e * 2 + 1] = sinf(ang); }
        for (int e = gt; e < SEQ * 16; e += NGT) { const int s = e >> 4, p = e & 15; const float pos = (float)(p < 8 ? (s >> 6) : (s & 63));
            const float inv = exp2f(-(float)(p & 7) * (13.287712379549449f / 8.0f)); const float ang = pos * inv;
            ((float*)(ws + WS_ROPEB))[(size_t)e * 2] = cosf(ang); ((float*)(ws + WS_ROPEB))[(size_t)e * 2 + 1] = sinf(ang); }
    }
}

__device__ __forceinline__ void norm_phase(const Params& P, unsigned char* ws, int layer, int which, int nrows, bool first, int lane, int wave, const float* pend_part, int pend_ns, const float* pend_gate) {
    const int gw = blockIdx.x * NWAVES + wave, NGW = gridDim.x * NWAVES;
    const float* g = (which == 0 ? P.in[I_N1G] : P.in[I_N2G]) + layer * DM;
    bf16_t* H = (bf16_t*)(ws + WS_H);
    for (int row = MLAT + gw; row < nrows; row += NGW) {
        float* wrow = (float*)(ws + WS_Y) + (size_t)(row - MLAT) * DM;
        const float* srow = first ? P.in[I_CTX] + (size_t)(row - MLAT) * DM : wrow;
        const float* mod = (const float*)(ws + WS_MOD) + (size_t)(layer * 9 + 8) * 6144 + which * 3 * DM;
        f32x4 v[4]; float ss = 0.f;
#pragma unroll
        for (int j = 0; j < 4; ++j) v[j] = *(const f32x4*)(srow + 4 * lane + 256 * j);
        if (pend_ns > 0) {
#pragma unroll
            for (int j = 0; j < 4; ++j) { const int col = 4 * lane + 256 * j; f32x4 a = (f32x4){0.f, 0.f, 0.f, 0.f};
                for (int ks = 0; ks < pend_ns; ++ks) a = a + *(const f32x4*)(pend_part + ((size_t)ks * MCTX + (row - MLAT)) * DM + col);
                v[j] = v[j] + *(const f32x4*)(pend_gate + col) * a; }
        }
#pragma unroll
        for (int j = 0; j < 4; ++j) ss += (v[j][0] * v[j][0] + v[j][1] * v[j][1]) + (v[j][2] * v[j][2] + v[j][3] * v[j][3]);
        const float rstd = rsqrtf(wave_sum(ss, lane) * (1.0f / DM) + EPS);
#pragma unroll
        for (int j = 0; j < 4; ++j) {
            const int col = 4 * lane + 256 * j;
            const f32x4 g4 = *(const f32x4*)(g + col), sh = *(const f32x4*)(mod + col), sc = *(const f32x4*)(mod + DM + col);
            const f32x4 h = (v[j] * rstd) * g4 * (sc + 1.0f) + sh;
            u32x2 w; w.x = cvt_pk_bf16(h[0], h[1]); w.y = cvt_pk_bf16(h[2], h[3]);
            *(u32x2*)(H + (size_t)row * DM + col) = w;
            if (first || pend_ns > 0) *(f32x4*)(wrow + col) = v[j];
        }
    }
    constexpr int NR = 2;
    bf16_t* XB = (bf16_t*)((unsigned char*)P.out + XB_OFF);
    for (int row0 = gw; row0 < MLAT; row0 += NR * NGW) {
        f32x4 v[NR][2][2]; float ss[NR];
#pragma unroll
        for (int r = 0; r < NR; ++r) { const int row = row0 + r * NGW; ss[r] = 0.f;
#pragma unroll
            for (int j = 0; j < 2; ++j) { const int col = 8 * lane + 512 * j;
                if (first) { v[r][j][0] = *(const f32x4*)(P.in[I_X] + (size_t)row * DM + col); v[r][j][1] = *(const f32x4*)(P.in[I_X] + (size_t)row * DM + col + 4); }
                else { const u32x4 w = *(const u32x4*)(XB + (size_t)row * DM + col); v[r][j][0] = bf4_to_f32((u32x2){w.x, w.y}); v[r][j][1] = bf4_to_f32((u32x2){w.z, w.w}); } } }
#pragma unroll
        for (int r = 0; r < NR; ++r)
#pragma unroll
            for (int j = 0; j < 2; ++j)
#pragma unroll
                for (int q = 0; q < 2; ++q) ss[r] += (v[r][j][q][0] * v[r][j][q][0] + v[r][j][q][1] * v[r][j][q][1]) + (v[r][j][q][2] * v[r][j][q][2] + v[r][j][q][3] * v[r][j][q][3]);
#pragma unroll
        for (int r = 0; r < NR; ++r) { const int row = row0 + r * NGW;
            const float rstd = rsqrtf(wave_sum(ss[r], lane) * (1.0f / DM) + EPS);
            const float* mod = (const float*)(ws + WS_MOD) + (size_t)(layer * 9 + (row >> 12)) * 6144 + which * 3 * DM;
#pragma unroll
            for (int j = 0; j < 2; ++j) { const int col = 8 * lane + 512 * j; u32x4 hw, xw;
#pragma unroll
                for (int q = 0; q < 2; ++q) {
                    const f32x4 g4 = *(const f32x4*)(g + col + 4 * q), sh = *(const f32x4*)(mod + col + 4 * q), sc = *(const f32x4*)(mod + DM + col + 4 * q);
                    const f32x4 h = (v[r][j][q] * rstd) * g4 * (sc + 1.0f) + sh;
                    if (q == 0) { hw.x = cvt_pk_bf16(h[0], h[1]); hw.y = cvt_pk_bf16(h[2], h[3]); xw.x = cvt_pk_bf16(v[r][j][q][0], v[r][j][q][1]); xw.y = cvt_pk_bf16(v[r][j][q][2], v[r][j][q][3]); }
                    else { hw.z = cvt_pk_bf16(h[0], h[1]); hw.w = cvt_pk_bf16(h[2], h[3]); xw.z = cvt_pk_bf16(v[r][j][q][0], v[r][j][q][1]); xw.w = cvt_pk_bf16(v[r][j][q][2], v[r][j][q][3]); }
                }
                *(u32x4*)(H + (size_t)row * DM + col) = hw;
                if (first) *(u32x4*)(XB + (size_t)row * DM + col) = xw;
            } }
    }
}

__device__ __forceinline__ void rownorm_phase(const Params& P, unsigned char* ws, int j, int lane, int wave) {
    const int gw = blockIdx.x * NWAVES + wave, NGW = gridDim.x * NWAVES;
    const bf16_t* D = (const bf16_t*)(ws + RB_D); bf16_t* CQ = (bf16_t*)(ws + RB_CQ); bf16_t* CKV = (bf16_t*)(ws + RB_CKV); bf16_t* Kd = (bf16_t*)(ws + RB_K);
    const float* qg = P.in[I_BQNG] + j * 512; const float* kg = P.in[I_BKVNG] + j * 256; const float* rope = (const float*)(ws + WS_ROPEB);
    for (int row = gw; row < MTOT; row += NGW) {
        const bool lat = row < MLAT; const int s = row & (SEQ - 1);
        const bf16_t* d = D + (size_t)row * DM;
        const u32x4 aw = *(const u32x4*)(d + 8 * lane); const u32x2 cw2 = *(const u32x2*)(d + 512 + 4 * lane);
        u32x2 kw = (u32x2){0u, 0u}; if (lane < 8) kw = *(const u32x2*)(d + 768 + 4 * lane);
        const f32x4 a0 = bf4_to_f32((u32x2){aw.x, aw.y}), a1 = bf4_to_f32((u32x2){aw.z, aw.w}), c0 = bf4_to_f32(cw2);
        f32x4 kr = bf4_to_f32(kw);
        const float sq = wave_sum((a0[0] * a0[0] + a0[1] * a0[1]) + (a0[2] * a0[2] + a0[3] * a0[3]) + (a1[0] * a1[0] + a1[1] * a1[1]) + (a1[2] * a1[2] + a1[3] * a1[3]), lane);
        const float sk = wave_sum((c0[0] * c0[0] + c0[1] * c0[1]) + (c0[2] * c0[2] + c0[3] * c0[3]), lane);
        const float rq = rsqrtf(sq * (1.0f / 512.0f) + EPS), rk = rsqrtf(sk * (1.0f / 256.0f) + EPS);
        { const f32x4 g0 = *(const f32x4*)(qg + 8 * lane), g1 = *(const f32x4*)(qg + 8 * lane + 4), g2 = *(const f32x4*)(kg + 4 * lane);
          const f32x4 h0 = a0 * rq * g0, h1 = a1 * rq * g1, h2 = c0 * rk * g2;
          u32x4 w4; w4.x = cvt_pk_bf16(h0[0], h0[1]); w4.y = cvt_pk_bf16(h0[2], h0[3]); w4.z = cvt_pk_bf16(h1[0], h1[1]); w4.w = cvt_pk_bf16(h1[2], h1[3]); *(u32x4*)(CQ + (size_t)row * 512 + 8 * lane) = w4;
          u32x2 w; w.x = cvt_pk_bf16(h2[0], h2[1]); w.y = cvt_pk_bf16(h2[2], h2[3]); *(u32x2*)(CKV + (size_t)row * 256 + 4 * lane) = w; }
        if (lat && lane < 8) { const f32x4 cs = *(const f32x4*)(rope + ((size_t)s * 16 + 2 * lane) * 2);
            kr = (f32x4){kr[0] * cs[0] - kr[1] * cs[1], kr[0] * cs[1] + kr[1] * cs[0], kr[2] * cs[2] - kr[3] * cs[3], kr[2] * cs[3] + kr[3] * cs[2]}; }
        const unsigned k0 = cvt_pk_bf16(kr[0], kr[1]), k1 = cvt_pk_bf16(kr[2], kr[3]);
        const unsigned b0 = (unsigned)__builtin_amdgcn_ds_bpermute((lane & 7) << 2, (int)k0), b1 = (unsigned)__builtin_amdgcn_ds_bpermute((lane & 7) << 2, (int)k1);
#pragma unroll
        for (int it = 0; it < 2; ++it) { const int h = (lane >> 3) + 8 * it; u32x2 w; w.x = b0; w.y = b1; *(u32x2*)(Kd + (size_t)row * 1536 + h * 96 + 64 + 4 * (lane & 7)) = w; }
    }
}

__device__ __forceinline__ void fixup_phase(const Params& P, unsigned char* ws, int layer, int nchunks, int lane, int wave) {
    const int gw = blockIdx.x * NWAVES + wave, NGW = gridDim.x * NWAVES;
    const float* E = (const float*)(ws + RF_EDGE); bf16_t* U = (bf16_t*)(ws + RF_U);
    const float* cw = P.in[I_FCW] + (size_t)layer * 3 * DFF;
    for (int it = gw; it < nchunks * 11; it += NGW) {
        const int c = it / 11, fb = it % 11, f = fb * 256 + 4 * lane;
        const bool start = c < MLAT / 64 ? ((c & 63) == 0) : (((c - MLAT / 64) & 3) == 0);
        if (start) continue;
        const float* eb = E + ((size_t)((c - 1) * 2 + 1) * 3) * DFF + f;
        const float* et = E + ((size_t)(c * 2) * 3) * DFF + f;
        const f32x4 ab = *(const f32x4*)eb, pb = *(const f32x4*)(eb + DFF), vb = *(const f32x4*)(eb + 2 * DFF);
        const f32x4 at = *(const f32x4*)et, pt = *(const f32x4*)(et + DFF), vt = *(const f32x4*)(et + 2 * DFF);
        const f32x4 w0 = *(const f32x4*)(cw + f), w2 = *(const f32x4*)(cw + 2 * DFF + f);
        const f32x4 xb = pb + w2 * at, xt = pt + w0 * ab;
        u32x2 w;
        w.x = cvt_pk_bf16(silu_f(xb[0]) * vb[0], silu_f(xb[1]) * vb[1]); w.y = cvt_pk_bf16(silu_f(xb[2]) * vb[2], silu_f(xb[3]) * vb[3]);
        *(u32x2*)(U + (size_t)(c * 64 - 1) * DFF + f) = w;
        w.x = cvt_pk_bf16(silu_f(xt[0]) * vt[0], silu_f(xt[1]) * vt[1]); w.y = cvt_pk_bf16(silu_f(xt[2]) * vt[2], silu_f(xt[3]) * vt[3]);
        *(u32x2*)(U + (size_t)(c * 64) * DFF + f) = w;
    }
}

constexpr float ATT_THR = 8.0f;
constexpr int AT_KB = 16384, AT_VB = 16384, AT_BUF = AT_KB + AT_VB;
template <int DQK, bool WIN, bool SAFE>
__device__ __forceinline__ bool attn_unit(const Params& P, unsigned char* ws, LAS unsigned char* lds, int layer_j, int u, int tid, int lane, int wave) {
    constexpr int NKS = DQK / 32, CPR = DQK / 8, NQ = 4;
    volatile LAS unsigned* badflag = (volatile LAS unsigned*)(lds + 4 * AT_BUF);
    const bf16_t* Q = (const bf16_t*)(ws + (WIN ? RA_Q : RB_Q)); const bf16_t* Kg = (const bf16_t*)(ws + (WIN ? RA_K : RB_K)); const bf16_t* VT = (const bf16_t*)(ws + (WIN ? RA_VT : RB_VT));
    bf16_t* O = (bf16_t*)(ws + WS_H);
    constexpr int QP = WIN ? 1024 : 1536, KP = WIN ? 256 : 1536, NHKV = WIN ? 4 : 16;
    const int fr = lane & 15, fq = lane >> 4;
    {
        const bool ctxq = u >= 1024;
        int b, hq, q0, nq;
        if (!ctxq) { q0 = (u & 7) * 512; hq = (u >> 3) & 15; b = u >> 7; nq = 512; } else { const int uc = u - 1024; hq = uc & 15; b = uc >> 4; q0 = 0; nq = 256; }
        const int hkv = WIN ? (hq >> 2) : hq;
        int s_lo = 0, s_hi = SEQ;
        if (WIN) { s_lo = q0 - 128 < 0 ? 0 : q0 - 128; s_hi = q0 + 512 + 128 > SEQ ? SEQ : q0 + 512 + 128; }
        const int nt = ctxq ? 4 : 4 + (s_hi - s_lo) / 64;
        const int qw = q0 + 64 * wave;
        const bool active = 64 * wave < nq;
        const size_t qrow0 = (ctxq ? (size_t)MLAT + b * CTXL : (size_t)b * SEQ) + qw;
        bf16x8 qf[NQ][NKS];
        if (active) {
#pragma unroll
            for (int qb = 0; qb < NQ; ++qb)
#pragma unroll
                for (int ks = 0; ks < NKS; ++ks) qf[qb][ks] = *(const bf16x8*)(Q + (qrow0 + 16 * qb + fr) * QP + hq * DQK + 32 * ks + 8 * fq);
        }
        bf16x8 ones8 = (bf16x8){0x3F80, 0x3F80, 0x3F80, 0x3F80, 0x3F80, 0x3F80, 0x3F80, 0x3F80}; asm volatile("" : "+v"(ones8));
        f32x4 o[4][NQ]; f32x4 negm[NQ]; f32x4 lacc[NQ];
        float m0 = 0.f, l0 = 0.f;
        if (WIN) { m0 = P.in[I_ASINK][layer_j * 16 + hq] * LOG2E; l0 = SAFE ? 1.f : __builtin_amdgcn_exp2f(m0); }
#pragma unroll
        for (int qb = 0; qb < NQ; ++qb) { negm[qb] = (f32x4){-m0, -m0, -m0, -m0}; lacc[qb] = (f32x4){l0, l0, l0, l0};
#pragma unroll
            for (int dv = 0; dv < 4; ++dv) o[dv][qb] = (f32x4){0.f, 0.f, 0.f, 0.f}; }
#define AT_KP(t) ((t) < 4 ? 64 * (t) : CTXL + s_lo + 64 * ((t) - 4))
#define AT_SWZ(r) ((((r) >> 3) & 3) << 2 | ((r) & 3))
#define AT_DMA(t) do { int ln_ = lane; asm volatile("" : "+v"(ln_)); const int kp0_ = AT_KP(t); const size_t kr0_ = kp0_ < CTXL ? (size_t)MLAT + b * CTXL + kp0_ : (size_t)b * SEQ + (kp0_ - CTXL); \
        LAS unsigned char* bb_ = lds + ((t) & 3) * AT_BUF + wave * 2048; \
        _Pragma("unroll") for (int i_ = 0; i_ < 2; ++i_) { const int p_ = wave * 2048 + i_ * 1024 + ln_ * 16, r_ = p_ >> 8, cs_ = (p_ >> 4) & 15; \
            const int ck_ = cs_ ^ AT_SWZ(r_), cv_ = cs_ ^ (r_ & 15); \
            if (ck_ < CPR) __builtin_amdgcn_global_load_lds((const unsigned*)(Kg + (kr0_ + r_) * KP + hkv * DQK + ck_ * 8), (LAS unsigned*)(bb_ + i_ * 1024), 16, 0, 0); \
            if (cv_ < 8) __builtin_amdgcn_global_load_lds((const unsigned*)(VT + ((size_t)(b * NHKV + hkv) * 64 + r_) * KPB + kp0_ + cv_ * 8), (LAS unsigned*)(bb_ + AT_KB + i_ * 1024), 16, 0, 0); } } while (0)
#define AT_BAR() do { asm volatile("s_waitcnt lgkmcnt(0)" ::: "memory"); __builtin_amdgcn_s_barrier(); asm volatile("" ::: "memory"); } while (0)
        asm volatile("s_waitcnt vmcnt(0)" ::: "memory");
        __syncthreads();
        AT_DMA(0); if (nt > 1) AT_DMA(1);
        if (tid == 0) badflag[0] = 0u;
        asm volatile("s_waitcnt vmcnt(0)" ::: "memory");
        AT_BAR();
        for (int t2 = 0; t2 < nt; t2 += 2) {
            if (t2 + 2 < nt) { AT_DMA(t2 + 2); AT_DMA(t2 + 3); }
          for (int t = t2; t < t2 + 2; ++t) {
            bool doit = active, need_mask = false; int k0 = 0;
            if (WIN && t >= 4) { k0 = s_lo + 64 * (t - 4);
                if (k0 > qw + 63 + 128 || k0 + 63 < qw - 128) doit = false;
                need_mask = !(k0 + 63 - qw <= 128 && qw + 63 - k0 <= 128); }
            if (doit) {
                int fr = lane & 15, fq = lane >> 4; asm volatile("" : "+v"(fr), "+v"(fq));
                const LAS unsigned char* kbase = lds + (t & 3) * AT_BUF; const LAS unsigned char* vbase = kbase + AT_KB;
#pragma unroll
                for (int g = 0; g < 2; ++g) {
                    f32x4 sc[2][NQ];
#pragma unroll
                    for (int kb = 0; kb < 2; ++kb)
#pragma unroll
                        for (int qb = 0; qb < NQ; ++qb) sc[kb][qb] = SAFE ? negm[qb] : (f32x4){0.f, 0.f, 0.f, 0.f};
                    bf16x8 kfa[NKS][2];
#pragma unroll
                    for (int ks = 0; ks < NKS; ++ks)
#pragma unroll
                        for (int kb = 0; kb < 2; ++kb) { const int r = 32 * g + 8 * (fr >> 2) + 4 * kb + (fr & 3);
                            kfa[ks][kb] = *(const LAS bf16x8*)(kbase + r * 256 + (((4 * ks + fq) ^ AT_SWZ(r)) << 4)); }
                    __builtin_amdgcn_sched_barrier(0);
#pragma unroll
                    for (int ks = 0; ks < NKS; ++ks)
#pragma unroll
                        for (int kb = 0; kb < 2; ++kb)
#pragma unroll
                            for (int qb = 0; qb < NQ; ++qb) sc[kb][qb] = __builtin_amdgcn_mfma_f32_16x16x32_bf16(kfa[ks][kb], qf[qb][ks], sc[kb][qb], 0, 0, 0);
                    if (WIN && need_mask) {
#pragma unroll
                        for (int qb = 0; qb < NQ; ++qb) { const int qpos = qw + 16 * qb + fr;
#pragma unroll
                            for (int kb = 0; kb < 2; ++kb)
#pragma unroll
                                for (int j = 0; j < 4; ++j) { const int dlt = qpos - (k0 + 32 * g + 8 * fq + 4 * kb + j); if (dlt > 128 || dlt < -128) sc[kb][qb][j] = -1e30f; } }
                    }
                    const bool first = !WIN && t == 0 && g == 0;
                    if (SAFE) {
                    float lmx[NQ], anymx = -1e30f;
#pragma unroll
                    for (int qb = 0; qb < NQ; ++qb) {
                        lmx[qb] = fmaxf(fmaxf(fmaxf(fmaxf(sc[0][qb][0], sc[0][qb][1]), sc[0][qb][2]), fmaxf(fmaxf(sc[0][qb][3], sc[1][qb][0]), sc[1][qb][1])), fmaxf(fmaxf(sc[1][qb][2], sc[1][qb][3]), -1e30f));
                        anymx = fmaxf(anymx, lmx[qb]);
                    }
                    if (first || __builtin_amdgcn_ballot_w64(anymx > ATT_THR) != 0ull) {
#pragma unroll
                        for (int qb = 0; qb < NQ; ++qb) {
                            float mx = lmx[qb]; mx = fmaxf(mx, shfl_f(mx, lane ^ 16)); mx = fmaxf(mx, shfl_f(mx, lane ^ 32));
                            const float delta = first ? mx : fmaxf(mx, 0.f);
                            const float alpha = first ? 1.f : __builtin_amdgcn_exp2f(-delta);
                            negm[qb] = negm[qb] - delta; sc[0][qb] = sc[0][qb] - delta; sc[1][qb] = sc[1][qb] - delta;
                            lacc[qb] = lacc[qb] * alpha;
#pragma unroll
                            for (int dv = 0; dv < 4; ++dv) o[dv][qb] = o[dv][qb] * alpha;
                        }
                    }
                    }
                    bf16x8 vfr[4];
#pragma unroll
                    for (int dv = 0; dv < 4; ++dv) vfr[dv] = *(const LAS bf16x8*)(vbase + (16 * dv + fr) * 256 + (((4 * g + fq) ^ fr) << 4));
                    __builtin_amdgcn_sched_barrier(0);
                    bf16x8 pf[NQ];
#pragma unroll
                    for (int qb = 0; qb < NQ; ++qb) {
                        float p[8];
#pragma unroll
                        for (int kb = 0; kb < 2; ++kb)
#pragma unroll
                            for (int j = 0; j < 4; ++j) p[4 * kb + j] = __builtin_amdgcn_exp2f(sc[kb][qb][j]);
                        u32x4 pk; pk.x = cvt_pk_v(p[0], p[1]); pk.y = cvt_pk_v(p[2], p[3]); pk.z = cvt_pk_v(p[4], p[5]); pk.w = cvt_pk_v(p[6], p[7]);
                        pf[qb] = __builtin_bit_cast(bf16x8, pk);
                        lacc[qb] = __builtin_amdgcn_mfma_f32_16x16x32_bf16(ones8, pf[qb], lacc[qb], 0, 0, 0);
                    }
#pragma unroll
                    for (int dv = 0; dv < 4; ++dv) {
#pragma unroll
                        for (int qb = 0; qb < NQ; ++qb) o[dv][qb] = __builtin_amdgcn_mfma_f32_16x16x32_bf16(vfr[dv], pf[qb], o[dv][qb], 0, 0, 0);
                    }
                }
            }
          }
            asm volatile("s_waitcnt vmcnt(0)" ::: "memory");
            AT_BAR();
        }
        bool wbad = false;
        if (active) {
#pragma unroll
            for (int qb = 0; qb < NQ; ++qb) {
                const float l = lacc[qb][0];
                if (!SAFE) wbad = wbad || !(l > 1e-30f && l < 1e30f);
                const float inv = 1.0f / l;
                bf16_t* op = O + (qrow0 + 16 * qb + fr) * DM + hq * 64 + 4 * fq;
#pragma unroll
                for (int dv = 0; dv < 4; ++dv) { const f32x4 v = o[dv][qb] * inv; u32x2 w; w.x = cvt_pk_v(v[0], v[1]); w.y = cvt_pk_v(v[2], v[3]); *(u32x2*)(op + 16 * dv) = w; }
            }
        }
#undef AT_DMA
#undef AT_BAR
#undef AT_KP
#undef AT_SWZ
        if (SAFE) return false;
        if (__builtin_amdgcn_ballot_w64(wbad) != 0ull && lane == 0) badflag[0] = 1u;
        __syncthreads();
        return badflag[0] != 0u;
    }
}
template <int DQK, bool WIN>
__device__ __forceinline__ void attn_phase(const Params& P, unsigned char* ws, LAS unsigned char* lds, int layer_j, bool with_ctx, int tid, int lane, int wave) {
    const int nunits = 1024 + (with_ctx ? 128 : 0);
    const int G_ = gridDim.x, bx_ = blockIdx.x, vcu = (G_ % 8 == 0) ? (bx_ % 8) * (G_ / 8) + bx_ / 8 : bx_;
    for (int u = vcu; u < nunits; u += G_) {
        if (attn_unit<DQK, WIN, false>(P, ws, lds, layer_j, u, tid, lane, wave)) (void)attn_unit<DQK, WIN, true>(P, ws, lds, layer_j, u, tid, lane, wave);
    }
    __syncthreads();
}

#define XB_TMO      128
#define XB_XCNT(j)  (256  + 64 * (j))
#define XB_XSUB(j)  (1280 + 64 * (j))
#define XB_XGEN(j)  (2304 + 64 * (j))
#define XB_TOP      3328
#define XB_TOPGEN   3392
#define XCD_BAR_WORDS 3456
#define XB_SPIN_CAP (1u << 18)

__device__ __forceinline__ unsigned xb_ld(unsigned* p)              { return __hip_atomic_load(p, __ATOMIC_RELAXED, __HIP_MEMORY_SCOPE_AGENT); }
__device__ __forceinline__ unsigned xb_add(unsigned* p, unsigned v) { return __hip_atomic_fetch_add(p, v, __ATOMIC_RELAXED, __HIP_MEMORY_SCOPE_AGENT); }
__device__ __forceinline__ unsigned xb_xcc_id() { return (unsigned)__builtin_amdgcn_s_getreg((3 << 11) | 20) & 0xFu; }
#define XB_SPIN(cond, bar) do { unsigned _sp = 0; while (cond) { __builtin_amdgcn_s_sleep(1); \
    if ((++_sp & 255u) == 0u) { if (xb_ld(&(bar)[XB_TMO])) break; if (_sp > XB_SPIN_CAP) { atomicAdd(&(bar)[XB_TMO], 1u); break; } } } } while (0)

struct XcdBarrier {
    unsigned* bar; unsigned x;
    volatile LAS unsigned* st;
};

__device__ __forceinline__ XcdBarrier xcd_barrier_post(unsigned* bar, volatile LAS unsigned* st) {
    XcdBarrier b; b.bar = bar; b.x = xb_xcc_id(); b.st = st;
    if (threadIdx.x == 0) (void)xb_add(&bar[XB_XCNT(b.x)], 1u);
    return b;
}
__device__ __forceinline__ void xcd_barrier_complete(unsigned* bar, unsigned x, unsigned& nloc, unsigned& nx) {
    const unsigned G = gridDim.x * gridDim.y * gridDim.z;
    unsigned sum, cnt, mine, sp = 0u;
    for (;;) {
        sum = 0u; cnt = 0u; mine = 0u;
#pragma unroll
        for (unsigned j = 0; j < 16; ++j) { const unsigned c = xb_ld(&bar[XB_XCNT(j)]); sum += c; cnt += (c > 0u) ? 1u : 0u; mine = (j == x) ? c : mine; }
        if (sum == G) break;
        __builtin_amdgcn_s_sleep(1);
        if ((++sp & 255u) == 0u) { if (xb_ld(&bar[XB_TMO])) break; if (sp > XB_SPIN_CAP) { atomicAdd(&bar[XB_TMO], 1u); break; } }
    }
    nloc = mine > 0u ? mine : 1u; nx = cnt > 0u ? cnt : 1u;
}

__device__ __forceinline__ void xcd_barrier(const XcdBarrier& b) {
    asm volatile("s_waitcnt vmcnt(0)" ::: "memory");
    __syncthreads();
    if (threadIdx.x == 0) {
        unsigned* bar = b.bar;
        __builtin_amdgcn_s_waitcnt(0);
        unsigned nloc = b.st[0], nx = b.st[1];
        if (nloc == 0u) { xcd_barrier_complete(bar, b.x, nloc, nx); b.st[0] = nloc; b.st[1] = nx; }
        const unsigned old = xb_add(&bar[XB_XSUB(b.x)], 1u);
        const unsigned gen = old / nloc;
        if (old + 1u == (gen + 1u) * nloc) {
            __builtin_amdgcn_fence(__ATOMIC_RELEASE, "agent");
            asm volatile("s_waitcnt vmcnt(0)" ::: "memory");
            const unsigned og = xb_add(&bar[XB_TOP], 1u);
            const unsigned tg = og / nx;
            if (og + 1u == (tg + 1u) * nx) xb_add(&bar[XB_TOPGEN], 1u);
            else XB_SPIN(xb_ld(&bar[XB_TOPGEN]) == tg, bar);
            __builtin_amdgcn_fence(__ATOMIC_ACQUIRE, "agent");
            xb_add(&bar[XB_XGEN(b.x)], 1u);
            asm volatile("s_waitcnt vmcnt(0)" ::: "memory");
        } else {
            XB_SPIN(xb_ld(&bar[XB_XGEN(b.x)]) == gen, bar);
            __builtin_amdgcn_fence(__ATOMIC_ACQUIRE, "agent");
            asm volatile("s_waitcnt vmcnt(0)" ::: "memory");
        }
    }
    __syncthreads();
}


__device__ __forceinline__ void final_norm(const Params& P, const XcdBarrier& xbar, int lane, int wave) {
    const int gw = blockIdx.x * NWAVES + wave, NGW = gridDim.x * NWAVES;
    const float* g = P.in[I_FINALG];
    const bf16_t* XB = (const bf16_t*)((unsigned char*)P.out + XB_OFF);
#define FN_LOAD(vv, row) do { _Pragma("unroll") for (int j = 0; j < 2; ++j) { const u32x4 w_ = *(const u32x4*)(XB + (size_t)(row) * DM + 8 * lane + 512 * j); vv[j][0] = bf4_to_f32((u32x2){w_.x, w_.y}); vv[j][1] = bf4_to_f32((u32x2){w_.z, w_.w}); } } while (0)
#define FN_STORE(vv, row) do { float ss_ = 0.f; _Pragma("unroll") for (int j = 0; j < 2; ++j) _Pragma("unroll") for (int q = 0; q < 2; ++q) ss_ += (vv[j][q][0] * vv[j][q][0] + vv[j][q][1] * vv[j][q][1]) + (vv[j][q][2] * vv[j][q][2] + vv[j][q][3] * vv[j][q][3]); \
        const float rstd_ = rsqrtf(wave_sum(ss_, lane) * (1.0f / DM) + EPS); \
        _Pragma("unroll") for (int j = 0; j < 2; ++j) _Pragma("unroll") for (int q = 0; q < 2; ++q) { const int col_ = 8 * lane + 512 * j + 4 * q; *(f32x4*)(P.out + (size_t)(row) * DM + col_) = (vv[j][q] * rstd_) * *(const f32x4*)(g + col_); } } while (0)
    for (int row = gw; row < 16384; row += NGW) { f32x4 v[2][2]; FN_LOAD(v, row); FN_STORE(v, row); }
    f32x4 vc[8][2][2];
#pragma unroll
    for (int k = 0; k < 8; ++k) { const int row = 16384 + gw + k * NGW; if (row < MLAT) FN_LOAD(vc[k], row); }
    xcd_barrier(xbar);
#pragma unroll
    for (int k = 0; k < 8; ++k) { const int row = 16384 + gw + k * NGW; if (row < MLAT) FN_STORE(vc[k], row); }
#undef FN_LOAD
#undef FN_STORE
}

#ifndef DBL_MASK
#define DBL_MASK 0
#endif
enum PhType { PH_PRO = 0, PH_NORM1, PH_NORM2, PH_G_QKVA, PH_ATT_A, PH_G_WOA, PH_G_D, PH_ROWNORM, PH_G_QB, PH_G_KVB, PH_ATT_B, PH_G_WOB, PH_G_FFN1, PH_FIXUP, PH_G_FFN2, PH_FINAL };
constexpr int NPH = 1 + 8 + 11 + 8 + 11 + 1;
__device__ __forceinline__ void phase_decode(int ph, int& type, int& layer, bool& nosync) {
    nosync = false; layer = 0;
    if (ph == 0) { type = PH_PRO; return; }
    if (ph == NPH - 1) { type = PH_FINAL; return; }
    int r = ph - 1; const int pair = r / 19; r -= pair * 19;
    if (r < 8) { layer = 2 * pair;
        type = r == 0 ? PH_NORM1 : r == 1 ? PH_G_QKVA : r == 2 ? PH_ATT_A : r == 3 ? PH_G_WOA : r == 4 ? PH_NORM2 : r == 5 ? PH_G_FFN1 : r == 6 ? PH_FIXUP : PH_G_FFN2;
    } else { r -= 8; layer = 2 * pair + 1;
        type = r == 0 ? PH_NORM1 : r == 1 ? PH_G_D : r == 2 ? PH_ROWNORM : r == 3 ? PH_G_QB : r == 4 ? PH_G_KVB : r == 5 ? PH_ATT_B : r == 6 ? PH_G_WOB : r == 7 ? PH_NORM2 : r == 8 ? PH_G_FFN1 : r == 9 ? PH_FIXUP : PH_G_FFN2;
        nosync = (r == 3);
    }
}

__global__ void __launch_bounds__(NTHR, 2) fwd_megakernel(Params P) {
    extern __shared__ __attribute__((aligned(16))) unsigned char lds_raw[];
    LAS unsigned char* lds = (LAS unsigned char*)lds_raw;
    cg::grid_group grid = cg::this_grid();
    { volatile LAS unsigned* misc = (volatile LAS unsigned*)(lds + 131072 + 512); if (threadIdx.x < 4) misc[threadIdx.x] = 0u; __syncthreads(); }
    const XcdBarrier xbar = xcd_barrier_post((unsigned*)(P.ws + WS_CTL), (volatile LAS unsigned*)(lds + 131072 + 512));
    for (int ph = P.ph_lo; ph < P.ph_hi; ++ph) {
        int type, layer; bool nosync; phase_decode(ph, type, layer, nosync);
        for (int rep = 0; rep < (((DBL_MASK >> type) & 1) ? 2 : 1); ++rep) {
        if (rep) xcd_barrier(xbar);
        int tid = threadIdx.x; asm volatile("" : "+v"(tid));
        size_t zoff = 0; asm volatile("" : "+s"(zoff)); unsigned char* ws = P.ws + zoff;
        const int lane = tid & 63, wave = __builtin_amdgcn_readfirstlane(tid >> 6);
        const bool with_ctx = layer < DEPTH - 1; const int j = layer >> 1;
        const int Mi = with_ctx ? MTOT : MLAT;
        if (type == PH_PRO) prologue(P, ws, lds, tid, lane, wave);
        else if (type == PH_NORM1) norm_phase(P, ws, layer, 0, MTOT, layer == 0, lane, wave, (const float*)(ws + PART_FFN2), layer > 0 ? NS_FFN2 : 0, (const float*)(ws + WS_MOD) + (size_t)((layer > 0 ? layer - 1 : 0) * 9 + 8) * 6144 + 5 * DM);
        else if (type == PH_NORM2) norm_phase(P, ws, layer, 1, Mi, false, lane, wave, (const float*)(ws + PART_WO), with_ctx ? NS_WO : 0, (const float*)(ws + WS_MOD) + (size_t)(layer * 9 + 8) * 6144 + 2 * DM);
        else if (type == PH_ROWNORM) rownorm_phase(P, ws, j, lane, wave);
        else if (type == PH_FIXUP) fixup_phase(P, ws, layer, Mi / 64, lane, wave);
        else if (type == PH_FINAL) final_norm(P, xbar, lane, wave);
#ifndef NO_ATTA
        else if (type == PH_ATT_A) attn_phase<64, true>(P, ws, lds, j, with_ctx, tid, lane, wave);
#endif
#ifndef NO_ATTB
        else if (type == PH_ATT_B) attn_phase<96, false>(P, ws, lds, j, with_ctx, tid, lane, wave);
#endif
        else {
            pg8::Gemm g; Epi E; E.ws = ws; E.X = P.out; E.layer = layer; E.gidx = 0; E.cw = nullptr; E.cb = nullptr; E.part = nullptr; E.kind = E_RES; int xrows = 0, nsplit = 1;
            const bf16_t* H = (const bf16_t*)(ws + WS_H);
            switch (type) {
            case PH_G_QKVA: g = pg8::Gemm{H, (const bf16_t*)(ws + W_AQKV) + (size_t)j * 1536 * 1024, MTOT, 1536, 1024}; E.kind = E_QKVA; break;
            case PH_G_WOA:  g = pg8::Gemm{H, (const bf16_t*)(ws + W_AWO) + (size_t)j * 1024 * 1024, MLAT, 1024, 1024}; E.kind = E_RES; E.gidx = 2; E.part = (float*)(ws + PART_WO); if (with_ctx) { xrows = MCTX; nsplit = NS_WO; } break;
            case PH_G_D:    g = pg8::Gemm{H, (const bf16_t*)(ws + W_BDN) + (size_t)j * 1024 * 1024, MTOT, 1024, 1024}; E.kind = E_D; break;
            case PH_G_QB:   g = pg8::Gemm{(const bf16_t*)(ws + RB_CQ), (const bf16_t*)(ws + W_BUQ) + (size_t)j * 1536 * 512, Mi, 1536, 512}; E.kind = E_QB; break;
            case PH_G_KVB:  g = pg8::Gemm{(const bf16_t*)(ws + RB_CKV), (const bf16_t*)(ws + W_BUKV) + (size_t)j * 2048 * 256, MTOT, 2048, 256}; E.kind = E_KVB; break;
            case PH_G_WOB:  g = pg8::Gemm{H, (const bf16_t*)(ws + W_BWO) + (size_t)j * 1024 * 1024, MLAT, 1024, 1024}; E.kind = E_RES; E.gidx = 2; E.part = (float*)(ws + PART_WO); if (with_ctx) { xrows = MCTX; nsplit = NS_WO; } break;
            case PH_G_FFN1: g = pg8::Gemm{H, (const bf16_t*)(ws + W_FIN) + (size_t)layer * 5632 * 1024, Mi, 5632, 1024}; E.kind = E_FFN1;
                            E.cw = P.in[I_FCW] + (size_t)layer * 3 * DFF; E.cb = P.in[I_FCB] + (size_t)layer * DFF; break;
            default:        g = pg8::Gemm{(const bf16_t*)(ws + RF_U), (const bf16_t*)(ws + W_FOUT) + (size_t)layer * 1024 * 2816, MLAT, 1024, 2816}; E.kind = E_RES; E.gidx = 5; E.part = (float*)(ws + PART_FFN2); if (with_ctx) { xrows = MCTX; nsplit = NS_FFN2; } break;
            }
            pg8::StaticOrder S; S.init(g.M, g.N, g.K, (int)gridDim.x, (int)blockIdx.x, xrows, nsplit);
            __syncthreads();
#ifndef NO_GEMM
            pg8::gemm_phase<Epi, pg8::StaticOrder, true, true>(lds, g, S, E, tid);
#endif
            __syncthreads();
        }
        }
        if (ph + 1 < P.ph_hi && !nosync) { if (P.ph_lo < 0) grid.sync(); else xcd_barrier(xbar); }
    }
}

extern "C" void kernel_launch(void* const* d_in, const int* in_sizes, int n_in, void* d_out, int out_size, void* d_ws, size_t ws_size, hipStream_t stream) {
    static int grid = 0;
    if (grid == 0) {
        if (n_in != 23 || ws_size < WS_END) { fprintf(stderr, "kernel_launch: unexpected n_in %d / ws_size %zu (need %zu)\n", n_in, ws_size, (size_t)WS_END); grid = -1; return; }
        int dev = 0, cus = 0, per_cu = 0;
        hipGetDevice(&dev); hipDeviceGetAttribute(&cus, hipDeviceAttributeMultiprocessorCount, dev);
        if (hipFuncSetAttribute((const void*)fwd_megakernel, hipFuncAttributeMaxDynamicSharedMemorySize, LDS_BYTES) != hipSuccess) { fprintf(stderr, "kernel_launch: hipFuncSetAttribute failed\n"); grid = -1; return; }
        if (hipOccupancyMaxActiveBlocksPerMultiprocessor(&per_cu, (const void*)fwd_megakernel, NTHR, LDS_BYTES) != hipSuccess || per_cu < 1) { fprintf(stderr, "kernel_launch: occupancy query says %d\n", per_cu); per_cu = 1; }
        (void)hipGetLastError();
        grid = cus * 1;
        if (grid <= 0) grid = 256;
    }
    if (grid < 0) return;
    Params p{};
    for (int i = 0; i < 23; ++i) p.in[i] = (const float*)d_in[i];
    p.out = (float*)d_out; p.ws = (unsigned char*)d_ws; p.ph_lo = 0; p.ph_hi = NPH;
    if (hipMemsetAsync((char*)d_ws + WS_CTL, 0, CTL_BYTES, stream) != hipSuccess) { fprintf(stderr, "kernel_launch: memset failed\n"); return; }
    void* args[] = {&p};
    hipError_t e = hipLaunchCooperativeKernel((const void*)fwd_megakernel, dim3(grid), dim3(NTHR), args, LDS_BYTES, stream);
    if (e != hipSuccess) fprintf(stderr, "cooperative launch failed: %s (grid %d)\n", hipGetErrorString(e), grid);
}
```

```cpp
#include <hip/hip_runtime.h>
#include <hip/hip_cooperative_groups.h>
#include <cstdio>
#include <cstdint>
namespace cg = cooperative_groups;

namespace pg8 {
#define PG8_LAS __attribute__((address_space(3)))
typedef unsigned short bf16_t;
typedef short bf16x8 __attribute__((ext_vector_type(8)));
typedef float f32x4 __attribute__((ext_vector_type(4)));
typedef unsigned u32x4 __attribute__((ext_vector_type(4)));
typedef unsigned u32x2 __attribute__((ext_vector_type(2)));
constexpr int BM = 256, BK = 64, HALF = 128, HTB = HALF * BK * 2  , STAGE_BYTES = 8 * HTB, NXCD = 8, WGM = 8;

__host__ __device__ __forceinline__ int lds_byte(int r, int c) { const int st = (r >> 4) * 2 + (c >> 5), rr = r & 15, cc = c & 31, ob = rr * 64 + cc * 2; return st * 1024 + (ob ^ (((ob >> 9) & 1) << 5)); }
__host__ __device__ __forceinline__ void stage_rc(int b, int& R, int& C) { const int st = b / 1024, sb = b % 1024, swz = sb ^ (((sb >> 9) & 1) << 5); R = (st >> 1) * 16 + swz / 64; C = (st & 1) * 32 + (swz % 64) / 2; }
__host__ __device__ __forceinline__ int perm32(int rho) { const int n = rho >> 4, i = rho & 15; return 8 * (i >> 2) + 4 * n + (i & 3); }

struct Unit { int pm, pn, koff, nt, ks; };
struct Gemm { const bf16_t* A; const bf16_t* Bt; int M, N, K; };

struct StaticOrder {
    int nM, nN, nwg, G, c, ntf, nsplit, nxt_units, ksz;
    __host__ __device__ void init(int M, int N, int K, int G_, int c_, int xrows = 0, int nsplit_ = 1) { nM = M / BM; nN = N / BM; nwg = nM * nN; G = G_; c = c_; ntf = K / BK;
        nsplit = nsplit_; nxt_units = (xrows / BM) * nN * nsplit_; ksz = K / nsplit_; }
    __host__ __device__ bool next(int i, Unit& u) const {
        const long L = (long)i * G + c; if (L >= nwg + nxt_units) return false;
        if (L >= nwg) { const int e = (int)L - nwg, ks = e % nsplit, tile = e / nsplit; u.pn = tile % nN; u.pm = nM + tile / nN; u.koff = ks * ksz; u.nt = ksz / BK; u.ks = ks; return true; }
        int wgid = (int)L; { const int q = nwg / NXCD, r = nwg % NXCD, xcd = wgid % NXCD, off = wgid / NXCD; wgid = (xcd < r ? xcd * (q + 1) : r * (q + 1) + (xcd - r) * q) + off; }
        const int nig = WGM * nN, gid = wgid / nig, fm = gid * WGM, gsz = (nM - fm) < WGM ? (nM - fm) : WGM;
        u.pm = fm + ((wgid % nig) % gsz); u.pn = (wgid % nig) / gsz; u.koff = 0; u.nt = ntf; u.ks = -1; return true;
    }
    __device__ __forceinline__ void a_ready(const Unit&) const {}
    __device__ __forceinline__ void done(const Unit&) const {}
};
__device__ __forceinline__ unsigned cvt_pk_bf16(float lo, float hi) { unsigned r; asm volatile("v_cvt_pk_bf16_f32 %0, %1, %2" : "=v"(r) : "v"(lo), "v"(hi)); return r; }
typedef __bf16 bf16x2_t __attribute__((ext_vector_type(2))); typedef float f32x2_t __attribute__((ext_vector_type(2)));
__device__ __forceinline__ unsigned cvt_pk_v(float lo, float hi) { return __builtin_bit_cast(unsigned, __builtin_convertvector((f32x2_t){lo, hi}, bf16x2_t)); }

template <class Epi, class Sched, bool ALIGN_EPI = false, bool SP2 = false>
__device__ __forceinline__ void gemm_phase(PG8_LAS unsigned char* lds, const Gemm g, const Sched& S, const Epi& E, const int tid) {
    const int wid = __builtin_amdgcn_readfirstlane(tid >> 6), lane = tid & 63, wr = wid >> 2, wc = wid & 3, fr = lane & 15, fq = lane >> 4;
    const int K = g.K;
    unsigned voffA[2], voffB[2];
#pragma unroll
    for (int i = 0; i < 2; ++i) { int R, C; stage_rc(tid * 16 + i * 8192, R, C); const int Rb = Epi::PERM ? ((R & ~31) + perm32(R & 31)) : R;
        voffA[i] = (unsigned)(R * K + C) * 2u; voffB[i] = (unsigned)(Rb * K + C) * 2u; }
    const size_t kstep = (size_t)(BK * 2);
    const size_t hstep = (size_t)HALF * K * 2;
    const size_t tstep = 2 * hstep;
    const unsigned ldsw = (unsigned)wid * 1024u;
    const int aoff = lds_byte(wr * 64 + fr, fq * 8), boff = lds_byte(wc * 32 + fr, fq * 8);
#define PG8_SA(b, h) (((b) * 2 + (h)) * HTB)
#define PG8_SB(b, h) ((4 + (b) * 2 + (h)) * HTB)
#define PG8_STAGE(bufoff, gbase, voff) do { _Pragma("unroll") for (int _i = 0; _i < 2; ++_i) \
        __builtin_amdgcn_global_load_lds((const unsigned*)((const char*)(gbase) + (voff)[_i]), (PG8_LAS unsigned*)(lds + (bufoff) + ldsw + _i * 8192), 16, 0, 0); } while (0)
#define PG8_LDA(dst, b, h) do { _Pragma("unroll") for (int m = 0; m < 4; ++m) _Pragma("unroll") for (int k = 0; k < 2; ++k) dst[m][k] = *(const PG8_LAS bf16x8*)(lds + PG8_SA(b, h) + aoff + m * 2048 + k * 1024); } while (0)
#define PG8_LDB(dst, b, h) do { _Pragma("unroll") for (int n = 0; n < 2; ++n) _Pragma("unroll") for (int k = 0; k < 2; ++k) dst[n][k] = *(const PG8_LAS bf16x8*)(lds + PG8_SB(b, h) + boff + n * 2048 + k * 1024); } while (0)
#define PG8_MMA(ai, bj, At, Bt) do { __builtin_amdgcn_s_setprio(1); _Pragma("unroll") for (int m = 0; m < 4; ++m) _Pragma("unroll") for (int n = 0; n < 2; ++n) _Pragma("unroll") for (int k = 0; k < 2; ++k) \
        acc[ai][bj][m][n] = __builtin_amdgcn_mfma_f32_16x16x32_bf16(Bt[n][k], At[m][k], acc[ai][bj][m][n], 0, 0, 0); __builtin_amdgcn_s_setprio(0); } while (0)
#define PG8_WAIT_V(n) asm volatile("s_waitcnt vmcnt(" #n ")" ::: "memory")
#define PG8_WAIT_L(n) asm volatile("s_waitcnt lgkmcnt(" #n ")" ::: "memory")
#define PG8_BAR __builtin_amdgcn_s_barrier()
#define PG8_SCHED __builtin_amdgcn_sched_barrier(0)
    Unit cur, nxt; int ui = 0;
    if (!S.next(0, cur)) return;
    f32x4 acc[2][2][4][2];
#pragma unroll
    for (int a = 0; a < 2; ++a)
#pragma unroll
        for (int b = 0; b < 2; ++b)
#pragma unroll
            for (int m = 0; m < 4; ++m)
#pragma unroll
                for (int n = 0; n < 2; ++n) acc[a][b][m][n] = (f32x4){0.f, 0.f, 0.f, 0.f};
    bf16x8 At[4][2], B0[2][2], B1[2][2];
    const char* cA = (const char*)g.A + (size_t)cur.pm * tstep + (size_t)cur.koff * 2; const char* cB = (const char*)g.Bt + (size_t)cur.pn * tstep + (size_t)cur.koff * 2;
    S.a_ready(cur);
    if constexpr (SP2) {
        PG8_STAGE(PG8_SB(0, 0), cB, voffB); PG8_STAGE(PG8_SB(0, 1), cB + hstep, voffB); PG8_STAGE(PG8_SA(0, 0), cA, voffA); PG8_STAGE(PG8_SA(0, 1), cA + hstep, voffA);
        if (wr == 1) PG8_BAR;
        PG8_WAIT_V(2); PG8_BAR;
        PG8_STAGE(PG8_SB(1, 0), cB + kstep, voffB); PG8_STAGE(PG8_SA(1, 0), cA + kstep, voffA); PG8_STAGE(PG8_SB(1, 1), cB + hstep + kstep, voffB);
        PG8_WAIT_V(6); PG8_BAR;
    } else {
        PG8_STAGE(PG8_SB(0, 0), cB, voffB); PG8_STAGE(PG8_SA(0, 0), cA, voffA); PG8_STAGE(PG8_SB(0, 1), cB + hstep, voffB); PG8_STAGE(PG8_SA(0, 1), cA + hstep, voffA);
        if (wr == 1) PG8_BAR;
        PG8_WAIT_V(4); PG8_BAR;
        PG8_STAGE(PG8_SB(1, 0), cB + kstep, voffB); PG8_STAGE(PG8_SA(1, 0), cA + kstep, voffA); PG8_STAGE(PG8_SB(1, 1), cB + hstep + kstep, voffB);
        PG8_WAIT_V(6); PG8_BAR;
    }
    for (;;) {
        const bool has_next = S.next(ui + 1, nxt);
        const char* nA = has_next ? (const char*)g.A + (size_t)nxt.pm * tstep + (size_t)nxt.koff * 2 : cA; const char* nB = has_next ? (const char*)g.Bt + (size_t)nxt.pn * tstep + (size_t)nxt.koff * 2 : cB;
        const int nt = cur.nt;
        for (int t = 0; t < nt; t += 2) {
            const bool last = (t == nt - 2);
            const char* a1 = cA + (size_t)(t + 1) * kstep;
            const char* a2 = last ? nA : cA + (size_t)(t + 2) * kstep; const char* b2 = last ? nB : cB + (size_t)(t + 2) * kstep;
            const char* a3 = a2 + kstep; const char* b3 = b2 + kstep;
            if (last && has_next) S.a_ready(nxt);
            if constexpr (SP2) {
            PG8_LDB(B0, 0, 0); PG8_LDB(B1, 0, 1); PG8_SCHED; PG8_LDA(At, 0, 0); PG8_STAGE(PG8_SA(1, 1), a1 + hstep, voffA);
            PG8_WAIT_V(8); PG8_WAIT_L(0); PG8_BAR; PG8_MMA(0, 0, At, B0); PG8_MMA(0, 1, At, B1); PG8_BAR; PG8_SCHED;
            PG8_LDA(At, 0, 1); PG8_STAGE(PG8_SB(0, 0), b2, voffB); PG8_STAGE(PG8_SB(0, 1), b2 + hstep, voffB); PG8_STAGE(PG8_SA(0, 0), a2, voffA);
            PG8_WAIT_V(8); PG8_WAIT_L(0); PG8_BAR; PG8_MMA(1, 0, At, B0); PG8_MMA(1, 1, At, B1); PG8_BAR; PG8_SCHED;
            PG8_LDB(B0, 1, 0); PG8_LDB(B1, 1, 1); PG8_SCHED; PG8_LDA(At, 1, 0); PG8_STAGE(PG8_SA(0, 1), a2 + hstep, voffA);
            PG8_WAIT_V(8); PG8_WAIT_L(0); PG8_BAR; PG8_MMA(0, 0, At, B0); PG8_MMA(0, 1, At, B1); PG8_BAR; PG8_SCHED;
            PG8_LDA(At, 1, 1); PG8_STAGE(PG8_SB(1, 0), b3, voffB); PG8_STAGE(PG8_SB(1, 1), b3 + hstep, voffB); PG8_STAGE(PG8_SA(1, 0), a3, voffA);
            PG8_WAIT_V(8); PG8_WAIT_L(0); PG8_BAR; PG8_MMA(1, 0, At, B0); PG8_MMA(1, 1, At, B1); PG8_BAR; PG8_SCHED;
            } else {
            PG8_LDB(B0, 0, 0); PG8_SCHED; PG8_LDA(At, 0, 0); PG8_STAGE(PG8_SA(1, 1), a1 + hstep, voffA);
            PG8_WAIT_L(8); PG8_BAR; PG8_WAIT_L(0); PG8_MMA(0, 0, At, B0); PG8_BAR; PG8_SCHED;
            PG8_LDB(B1, 0, 1); PG8_STAGE(PG8_SB(0, 0), b2, voffB);
            PG8_BAR; PG8_WAIT_L(0); PG8_MMA(0, 1, At, B1); PG8_BAR;
            PG8_LDA(At, 0, 1); PG8_STAGE(PG8_SA(0, 0), a2, voffA);
            PG8_BAR; PG8_WAIT_L(0); PG8_MMA(1, 0, At, B0); PG8_BAR; PG8_SCHED;
            PG8_STAGE(PG8_SB(0, 1), b2 + hstep, voffB);
            PG8_WAIT_V(6); PG8_BAR; PG8_MMA(1, 1, At, B1); PG8_BAR;
            PG8_LDB(B0, 1, 0); PG8_SCHED; PG8_LDA(At, 1, 0); PG8_STAGE(PG8_SA(0, 1), a2 + hstep, voffA);
            PG8_WAIT_L(8); PG8_BAR; PG8_WAIT_L(0); PG8_MMA(0, 0, At, B0); PG8_BAR; PG8_SCHED;
            PG8_LDB(B1, 1, 1); PG8_STAGE(PG8_SB(1, 0), b3, voffB);
            PG8_BAR; PG8_WAIT_L(0); PG8_MMA(0, 1, At, B1); PG8_BAR;
            PG8_LDA(At, 1, 1); PG8_STAGE(PG8_SA(1, 0), a3, voffA);
            PG8_BAR; PG8_WAIT_L(0); PG8_MMA(1, 0, At, B0); PG8_BAR; PG8_SCHED;
            PG8_STAGE(PG8_SB(1, 1), b3 + hstep, voffB);
            PG8_WAIT_V(6); PG8_BAR; PG8_MMA(1, 1, At, B1); PG8_BAR;
            }
        }
        if constexpr (ALIGN_EPI) { if (wr == 0) PG8_BAR; }
        if constexpr (!Epi::AFTER_DRAIN) { E(acc, cur, wr, wc, fr, fq); S.done(cur); }
        if (!has_next) break;
#pragma unroll
        for (int a = 0; a < 2; ++a)
#pragma unroll
            for (int b = 0; b < 2; ++b)
#pragma unroll
                for (int m = 0; m < 4; ++m)
#pragma unroll
                    for (int n = 0; n < 2; ++n) acc[a][b][m][n] = (f32x4){0.f, 0.f, 0.f, 0.f};
        cur = nxt; cA = nA; cB = nB; ++ui;
        if constexpr (ALIGN_EPI) { if (wr == 1) PG8_BAR; }
    }
    PG8_WAIT_V(0);
    if constexpr (!ALIGN_EPI) { if (wr == 0) PG8_BAR; }
    PG8_BAR;
    if constexpr (Epi::AFTER_DRAIN) { E.fused(acc, cur, wr, wc, fr, fq, lds, wid, lane); S.done(cur); }
#undef PG8_SA
#undef PG8_SB
#undef PG8_STAGE
#undef PG8_LDA
#undef PG8_LDB
#undef PG8_MMA
#undef PG8_WAIT_V
#undef PG8_WAIT_L
#undef PG8_BAR
#undef PG8_SCHED
}
}

using pg8::bf16_t; using pg8::bf16x8; using pg8::f32x4; using pg8::u32x4; using pg8::u32x2; using pg8::cvt_pk_bf16; using pg8::cvt_pk_v;
#define LAS __attribute__((address_space(3)))
constexpr int DM = 1024, NBATCH = 8, SEQ = 4096, CTXL = 256, DEPTH = 4;
constexpr int MLAT = NBATCH * SEQ, MCTX = NBATCH * CTXL, MTOT = MLAT + MCTX;
constexpr int KPB = CTXL + SEQ;
constexpr int DFF = 2816;
constexpr int NCHUNK = MTOT / 64;
constexpr float LOG2E = 1.4426950408889634f;
constexpr float C2A = 0.125f * LOG2E;
constexpr float C2B = 0.10206207261596577f * LOG2E;
constexpr float EPS = 1e-6f;
constexpr int NWAVES = 8, NTHR = 512;
constexpr int LDS_BYTES = 147456;

constexpr size_t MiB = 1u << 20;
constexpr size_t WS_Y = 0;
constexpr size_t WS_MOD = 8 * MiB;
constexpr size_t WS_CTL = 8 * MiB + 960 * 1024, CTL_BYTES = 16384;
constexpr size_t WS_ROPEA = 9 * MiB;
constexpr size_t WS_ROPEB = 10 * MiB;
constexpr size_t WS_W = 11 * MiB;
constexpr size_t W_AQKV = WS_W;
constexpr size_t W_AWO = W_AQKV + 6 * MiB;
constexpr size_t W_BDN = W_AWO + 4 * MiB;
constexpr size_t W_BUQ = W_BDN + 4 * MiB;
constexpr size_t W_BUKV = W_BUQ + 3 * MiB;
constexpr size_t W_BWO = W_BUKV + 2 * MiB;
constexpr size_t W_FIN = W_BWO + 4 * MiB;
constexpr size_t W_FOUT = W_FIN + 44 * MiB;
constexpr size_t WS_H = 100 * MiB;
constexpr size_t WS_R = 168 * MiB;
constexpr size_t RA_Q = WS_R, RA_K = WS_R + 68 * MiB, RA_VT = WS_R + 85 * MiB;
constexpr size_t RB_CQ = WS_R, RB_CKV = WS_R + 34 * MiB, RB_K = WS_R + 51 * MiB, RB_Q = WS_R + 153 * MiB, RB_VT = WS_R + 255 * MiB, RB_D = RB_Q;
constexpr size_t RF_U = WS_R, RF_EDGE = WS_R + 187 * MiB;
constexpr size_t PART_WO = WS_R, PART_FFN2 = WS_R + 224 * MiB;
constexpr int NS_WO = 2, NS_FFN2 = 2;
constexpr size_t XB_OFF = 64 * MiB;
constexpr size_t WS_END = WS_R + 323 * MiB;
static_assert(W_FOUT + 22 * MiB <= WS_H, "weights fit");
static_assert((size_t)NCHUNK * 2 * 3 * DFF * 4 <= 36 * MiB, "edge buffer");

struct Params { const float* in[23]; float* out; unsigned char* ws; int ph_lo, ph_hi; };
enum InIdx { I_X = 0, I_C, I_CTX, I_CCTX, I_MODW, I_MODB, I_N1G, I_N2G, I_AWQKV, I_AWO, I_ASINK, I_BWDOWN, I_BQNG, I_BWUQ, I_BKVNG, I_BWUK, I_BWUV, I_BWO, I_FWIN, I_FCW, I_FCB, I_FWOUT, I_FINALG };

__device__ __forceinline__ float shfl_f(float v, int src_lane) { return __builtin_bit_cast(float, __builtin_amdgcn_ds_bpermute(src_lane << 2, __builtin_bit_cast(int, v))); }
__device__ __forceinline__ float wave_sum(float v, int lane) {
#pragma unroll
    for (int o = 1; o < 64; o <<= 1) v += shfl_f(v, lane ^ o);
    return v;
}
__device__ __forceinline__ f32x4 bf4_to_f32(u32x2 w) { return (f32x4){__builtin_bit_cast(float, w.x << 16), __builtin_bit_cast(float, w.x & 0xffff0000u), __builtin_bit_cast(float, w.y << 16), __builtin_bit_cast(float, w.y & 0xffff0000u)}; }
__device__ __forceinline__ float silu_f(float a) { return a * __builtin_amdgcn_rcpf(1.0f + __expf(-a)); }

enum EpiKind { E_QKVA = 0, E_RES, E_D, E_QB, E_KVB, E_FFN1 };
struct Epi {
    static constexpr bool PERM = true, AFTER_DRAIN = false;
    int kind, layer, gidx;
    unsigned char* ws; float* X; const float* cw; const float* cb; float* part;
    __device__ __forceinline__ void operator()(const f32x4 (&acc)[2][2][4][2], const pg8::Unit& u, int wr, int wc, int fr, int fq) const {
        asm volatile("" : "+v"(fr), "+v"(fq));
        const int rowt = u.pm * 256;
        const bool lat = rowt < MLAT;
        const int b = lat ? (rowt >> 12) : ((rowt - MLAT) >> 8);
        const int p0 = lat ? (rowt & (SEQ - 1)) : (rowt - MLAT) & (CTXL - 1);
        const int kp_t = lat ? CTXL + p0 : p0;
        const int lane_r = wr * 64 + fr;
        const int colt = u.pn * 256 + wc * 32 + 8 * fq;
#define EPI_PK8(v0, v1, w) do { (w).x = cvt_pk_v((v0)[0], (v0)[1]); (w).y = cvt_pk_v((v0)[2], (v0)[3]); (w).z = cvt_pk_v((v1)[0], (v1)[1]); (w).w = cvt_pk_v((v1)[2], (v1)[3]); } while (0)
#define EPI_ROPE(v, cs) (f32x4){(v)[0] * (cs)[0] - (v)[1] * (cs)[1], (v)[0] * (cs)[1] + (v)[1] * (cs)[0], (v)[2] * (cs)[2] - (v)[3] * (cs)[3], (v)[2] * (cs)[3] + (v)[3] * (cs)[2]}
        if (kind == E_D) {
            bf16_t* dst = (bf16_t*)(ws + RB_D) + (size_t)rowt * DM;
#pragma unroll
            for (int ai = 0; ai < 2; ++ai)
#pragma unroll
                for (int m = 0; m < 4; ++m)
#pragma unroll
                    for (int bj = 0; bj < 2; ++bj) { if (colt + bj * 128 < 800) { u32x4 w; EPI_PK8(acc[ai][bj][m][0], acc[ai][bj][m][1], w); *(u32x4*)(dst + (size_t)(lane_r + ai * 128 + m * 16) * DM + colt + bj * 128) = w; } }
        } else if (kind == E_RES && u.ks >= 0) {
            float* dst = part + ((size_t)u.ks * MCTX + (rowt - MLAT)) * DM;
#pragma unroll
            for (int ai = 0; ai < 2; ++ai)
#pragma unroll
                for (int m = 0; m < 4; ++m)
#pragma unroll
                    for (int bj = 0; bj < 2; ++bj)
#pragma unroll
                        for (int n = 0; n < 2; ++n) *(f32x4*)(dst + (size_t)(lane_r + ai * 128 + m * 16) * DM + colt + bj * 128 + n * 4) = acc[ai][bj][m][n];
        } else if (kind == E_RES && lat) {
            bf16_t* dst = (bf16_t*)((unsigned char*)X + XB_OFF) + (size_t)rowt * DM;
            const float* gate = (const float*)(ws + WS_MOD) + (size_t)(layer * 9 + b) * 6144 + gidx * DM;
#pragma unroll
            for (int bj = 0; bj < 2; ++bj) {
                const int col = colt + bj * 128; const f32x4 g0 = *(const f32x4*)(gate + col), g1 = *(const f32x4*)(gate + col + 4);
                u32x4 xw[2][4];
#pragma unroll
                for (int ai = 0; ai < 2; ++ai)
#pragma unroll
                    for (int m = 0; m < 4; ++m) xw[ai][m] = *(const u32x4*)(dst + (size_t)(lane_r + ai * 128 + m * 16) * DM + col);
#pragma unroll
                for (int ai = 0; ai < 2; ++ai)
#pragma unroll
                    for (int m = 0; m < 4; ++m) { bf16_t* p = dst + (size_t)(lane_r + ai * 128 + m * 16) * DM + col;
                        const f32x4 x0 = bf4_to_f32((u32x2){xw[ai][m].x, xw[ai][m].y}) + g0 * acc[ai][bj][m][0], x1 = bf4_to_f32((u32x2){xw[ai][m].z, xw[ai][m].w}) + g1 * acc[ai][bj][m][1];
                        u32x4 w; EPI_PK8(x0, x1, w); *(u32x4*)p = w; }
            }
        } else if (kind == E_RES) {
            float* dst = (float*)(ws + WS_Y) + (size_t)(rowt - MLAT) * DM;
            const float* gate = (const float*)(ws + WS_MOD) + (size_t)(layer * 9 + 8) * 6144 + gidx * DM;
#pragma unroll
            for (int bj = 0; bj < 2; ++bj)
#pragma unroll
                for (int n = 0; n < 2; ++n) {
                    const int col = colt + bj * 128 + n * 4; const f32x4 g4 = *(const f32x4*)(gate + col);
#pragma unroll
                    for (int ai = 0; ai < 2; ++ai)
#pragma unroll
                        for (int m = 0; m < 4; ++m) { float* p = dst + (size_t)(lane_r + ai * 128 + m * 16) * DM + col; f32x4 x4 = *(f32x4*)p; x4 = x4 + g4 * acc[ai][bj][m][n]; *(f32x4*)p = x4; }
                }
        } else if (kind == E_QKVA) {
            const float* rope = (const float*)(ws + WS_ROPEA);
            bf16_t* Q = (bf16_t*)(ws + RA_Q); bf16_t* Kd = (bf16_t*)(ws + RA_K); bf16_t* VT = (bf16_t*)(ws + RA_VT);
            const int sect = u.pn < 4 ? 0 : (u.pn == 4 ? 1 : 2);
#pragma unroll
            for (int ai = 0; ai < 2; ++ai)
#pragma unroll
                for (int m = 0; m < 4; ++m) {
                    const int rl = lane_r + ai * 128 + m * 16, row = rowt + rl, s = p0 + rl;
#pragma unroll
                    for (int bj = 0; bj < 2; ++bj) {
                        const int col = colt + bj * 128; f32x4 v0 = acc[ai][bj][m][0], v1 = acc[ai][bj][m][1];
                        if (sect < 2) {
                            if (lat) { const float* rp = rope + ((size_t)s * 32 + ((col & 63) >> 1)) * 2; const f32x4 c0 = *(const f32x4*)rp, c1 = *(const f32x4*)(rp + 4);
                                v0 = EPI_ROPE(v0, c0); v1 = EPI_ROPE(v1, c1); }
                            u32x4 w;
                            if (sect == 0) { v0 = v0 * C2A; v1 = v1 * C2A; EPI_PK8(v0, v1, w); *(u32x4*)(Q + (size_t)row * 1024 + col) = w; }
                            else { EPI_PK8(v0, v1, w); *(u32x4*)(Kd + (size_t)row * 256 + (col - 1024)) = w; }
                        } else {
#pragma unroll
                            for (int n = 0; n < 2; ++n) { const f32x4 v = n ? v1 : v0;
                                const int c2 = col + 4 * n - 1280, kvh = c2 >> 6, d = c2 & 63;
                                bf16_t* vp = VT + ((size_t)(b * 4 + kvh) * 64 + d) * KPB + kp_t + rl;
                                const unsigned w0 = cvt_pk_bf16(v[0], v[1]), w1 = cvt_pk_bf16(v[2], v[3]);
                                vp[0] = (bf16_t)(w0 & 0xffffu); vp[KPB] = (bf16_t)(w0 >> 16); vp[2 * KPB] = (bf16_t)(w1 & 0xffffu); vp[3 * KPB] = (bf16_t)(w1 >> 16); }
                        }
                    }
                }
        } else if (kind == E_QB) {
            const float* rope = (const float*)(ws + WS_ROPEB); bf16_t* Q = (bf16_t*)(ws + RB_Q);
#pragma unroll
            for (int ai = 0; ai < 2; ++ai)
#pragma unroll
                for (int m = 0; m < 4; ++m) {
                    const int rl = lane_r + ai * 128 + m * 16, row = rowt + rl, s = p0 + rl;
#pragma unroll
                    for (int bj = 0; bj < 2; ++bj) {
                        const int col = colt + bj * 128; f32x4 v0 = acc[ai][bj][m][0], v1 = acc[ai][bj][m][1];
                        const int d = col % 96;
                        if (lat && d >= 64) { const float* rp = rope + ((size_t)s * 16 + ((d - 64) >> 1)) * 2; const f32x4 c0 = *(const f32x4*)rp, c1 = *(const f32x4*)(rp + 4);
                            v0 = EPI_ROPE(v0, c0); v1 = EPI_ROPE(v1, c1); }
                        v0 = v0 * C2B; v1 = v1 * C2B; u32x4 w; EPI_PK8(v0, v1, w); *(u32x4*)(Q + (size_t)row * 1536 + col) = w;
                    }
                }
        } else if (kind == E_KVB) {
            bf16_t* Kd = (bf16_t*)(ws + RB_K); bf16_t* VT = (bf16_t*)(ws + RB_VT);
            const bool isv = u.pn >= 4;
#pragma unroll
            for (int ai = 0; ai < 2; ++ai)
#pragma unroll
                for (int m = 0; m < 4; ++m) {
                    const int rl = lane_r + ai * 128 + m * 16, row = rowt + rl;
#pragma unroll
                    for (int bj = 0; bj < 2; ++bj) {
                        const int col = (colt + bj * 128) & 1023, h = col >> 6, d = col & 63; const f32x4 v0 = acc[ai][bj][m][0], v1 = acc[ai][bj][m][1];
                        if (!isv) { u32x4 w; EPI_PK8(v0, v1, w); *(u32x4*)(Kd + (size_t)row * 1536 + h * 96 + d) = w; }
                        else {
#pragma unroll
                            for (int n = 0; n < 2; ++n) { const f32x4 v = n ? v1 : v0; bf16_t* vp = VT + ((size_t)(b * 16 + h) * 64 + d + 4 * n) * KPB + kp_t + rl;
                                const unsigned w0 = cvt_pk_bf16(v[0], v[1]), w1 = cvt_pk_bf16(v[2], v[3]);
                                vp[0] = (bf16_t)(w0 & 0xffffu); vp[KPB] = (bf16_t)(w0 >> 16); vp[2 * KPB] = (bf16_t)(w1 & 0xffffu); vp[3 * KPB] = (bf16_t)(w1 >> 16); }
                        }
                    }
                }
        } else {
            bf16_t* U = (bf16_t*)(ws + RF_U); float* EDGE = (float*)(ws + RF_EDGE);
#pragma unroll
            for (int ai = 0; ai < 2; ++ai) {
                const int chunk = u.pm * 4 + ai * 2 + wr;
                const int cseq = lat ? (chunk & 63) : ((chunk - MLAT / 64) & 3);
                const bool seq_first = cseq == 0, seq_last = lat ? (cseq == 63) : (cseq == 3);
                const int fb = u.pn * 128 + wc * 32 + 8 * fq;
                u32x2 uw0[4];
#pragma unroll
                for (int n = 0; n < 2; ++n) {
                    const int f0 = fb + 4 * n;
                    const f32x4 w0 = *(const f32x4*)(cw + f0), w1 = *(const f32x4*)(cw + DFF + f0), w2 = *(const f32x4*)(cw + 2 * DFF + f0), bb = *(const f32x4*)(cb + f0);
                    f32x4 pre[4];
#pragma unroll
                    for (int j = 0; j < 4; ++j) {
                        float t[4], up[4], dn[4];
#pragma unroll
                        for (int m = 0; m < 4; ++m) { t[m] = acc[ai][0][m][n][j];
                            up[m] = __builtin_bit_cast(float, __builtin_amdgcn_update_dpp(0, __builtin_bit_cast(int, t[m]), 0x121, 0xf, 0xf, false));
                            dn[m] = __builtin_bit_cast(float, __builtin_amdgcn_update_dpp(0, __builtin_bit_cast(int, t[m]), 0x12F, 0xf, 0xf, false)); }
#pragma unroll
                        for (int m = 0; m < 4; ++m) {
                            const float pv = (fr == 0) ? (m > 0 ? up[m > 0 ? m - 1 : 0] : 0.f) : up[m];
                            const float nx = (fr == 15) ? (m < 3 ? dn[m < 3 ? m + 1 : 3] : 0.f) : dn[m];
                            pre[m][j] = w0[j] * pv + w1[j] * t[m] + w2[j] * nx + bb[j];
                        }
                    }
#pragma unroll
                    for (int m = 0; m < 4; ++m) {
                        const bool top = (m == 0 && fr == 0), bot = (m == 3 && fr == 15);
                        const bool need_fix = (top && !seq_first) || (bot && !seq_last);
                        const f32x4 vv = acc[ai][1][m][n];
                        if (top || bot) {
                            float* e = EDGE + ((size_t)(chunk * 2 + (bot ? 1 : 0)) * 3) * DFF + f0;
                            *(f32x4*)e = acc[ai][0][m][n];
                            if (need_fix) { *(f32x4*)(e + DFF) = pre[m]; *(f32x4*)(e + 2 * DFF) = vv; }
                        }
                        u32x2 w; w.x = cvt_pk_bf16(silu_f(pre[m][0]) * vv[0], silu_f(pre[m][1]) * vv[1]); w.y = cvt_pk_bf16(silu_f(pre[m][2]) * vv[2], silu_f(pre[m][3]) * vv[3]);
                        if (n == 0) uw0[m] = w;
                        else if (!need_fix) { const int row = rowt + lane_r + ai * 128 + m * 16; *(u32x4*)(U + (size_t)row * DFF + fb) = (u32x4){uw0[m].x, uw0[m].y, w.x, w.y}; }
                    }
                }
            }
        }
#undef EPI_PK8
#undef EPI_ROPE
    }
};

#define TR_LOAD(t, item) do { const int nblk_ = N / 32, kb_ = (item) / nblk_, nb_ = (item) % nblk_; \
    _Pragma("unroll") for (int i = 0; i < 8; ++i) (t)[i] = *(const f32x4*)(W + (size_t)(64 * kb_ + 8 * i + (lane >> 3)) * N + 32 * nb_ + 4 * (lane & 7)); } while (0)
__device__ __forceinline__ void transpose_put(const f32x4 (&t)[8], int K, int N, bf16_t* WT, int mode, int row_off, LAS float* scr, int item, int lane) {
    const int nblk = N / 32, kb = item / nblk, nb = item % nblk, k0 = 64 * kb, n0 = 32 * nb;
#pragma unroll
    for (int i = 0; i < 8; ++i) { LAS float* d = scr + (8 * i + (lane >> 3)) * 33 + 4 * (lane & 7); d[0] = t[i][0]; d[1] = t[i][1]; d[2] = t[i][2]; d[3] = t[i][3]; }
    asm volatile("s_waitcnt lgkmcnt(0)" ::: "memory");
    int r0;
    if (mode == 0) r0 = row_off + n0;
    else { const int c = n0 < DFF ? n0 : n0 - DFF; r0 = 256 * (c >> 7) + (c & 127) + (n0 < DFF ? 0 : 128); }
    const int c = lane & 7;
#pragma unroll
    for (int j = 0; j < 4; ++j) { const int n = (lane >> 3) + 8 * j; const LAS float* s = scr + (8 * c) * 33 + n;
        u32x4 o; o.x = cvt_pk_bf16(s[0 * 33], s[1 * 33]); o.y = cvt_pk_bf16(s[2 * 33], s[3 * 33]); o.z = cvt_pk_bf16(s[4 * 33], s[5 * 33]); o.w = cvt_pk_bf16(s[6 * 33], s[7 * 33]);
        *(u32x4*)(WT + (size_t)(r0 + n) * K + k0 + 8 * c) = o; }
    asm volatile("s_waitcnt lgkmcnt(0)" ::: "memory");
}
__device__ __forceinline__ void transpose_matrix(const float* W, int K, int N, bf16_t* WT, int mode, int row_off, LAS float* scr, int gw, int NGW, int lane) {
    const int nitems = (K / 64) * (N / 32);
    int it = gw; if (it >= nitems) return;
    f32x4 ta[8], tb[8];
    TR_LOAD(ta, it);
    for (;;) {
        const int it1 = it + NGW; if (it1 < nitems) TR_LOAD(tb, it1);
        transpose_put(ta, K, N, WT, mode, row_off, scr, it, lane);
        if (it1 >= nitems) break;
        const int it2 = it1 + NGW; if (it2 < nitems) TR_LOAD(ta, it2);
        transpose_put(tb, K, N, WT, mode, row_off, scr, it1, lane);
        if (it2 >= nitems) break;
        it = it2;
    }
}
#undef TR_LOAD
__device__ __forceinline__ void prologue(const Params& P, unsigned char* ws, LAS unsigned char* lds, int tid, int lane, int wave) {
    const int G = gridDim.x, gw = blockIdx.x * NWAVES + wave, NGW = G * NWAVES;
    {
        LAS float* sv = (LAS float*)lds;
        LAS float* red = (LAS float*)(lds + 9 * 1024 * 4);
        bool loaded = false;
        for (int item = blockIdx.x; item < 4 * 48; item += G) {
            if (!loaded) {
                for (int e = tid; e < 9 * 1024; e += NTHR) { const float cv = e < 8192 ? P.in[I_C][e] : P.in[I_CCTX][e - 8192]; sv[e] = cv / (1.0f + __expf(-cv)); }
                loaded = true;
            }
            __syncthreads();
            const int li = item / 48, cb = item % 48, c4 = tid & 31, kg = tid >> 5;
            const float* W = P.in[I_MODW] + (size_t)li * 1024 * 6144 + (size_t)cb * 128 + 4 * c4;
            f32x4 a[9];
#pragma unroll
            for (int v = 0; v < 9; ++v) a[v] = (f32x4){0.f, 0.f, 0.f, 0.f};
#pragma unroll 8
            for (int k = kg * 64; k < kg * 64 + 64; ++k) { const f32x4 w = *(const f32x4*)(W + (size_t)k * 6144);
#pragma unroll
                for (int v = 0; v < 9; ++v) a[v] = a[v] + w * sv[v * 1024 + k]; }
#pragma unroll
            for (int v = 0; v < 9; ++v) *(LAS f32x4*)(red + (kg * 9 + v) * 128 + 4 * c4) = a[v];
            __syncthreads();
            for (int e = tid; e < 9 * 128; e += NTHR) { const int v = e >> 7, cc = e & 127; float sum = P.in[I_MODB][li * 6144 + cb * 128 + cc];
#pragma unroll
                for (int q = 0; q < 16; ++q) sum += red[(q * 9 + v) * 128 + cc];
                ((float*)(ws + WS_MOD))[(size_t)(li * 9 + v) * 6144 + cb * 128 + cc] = sum; }
        }
        __syncthreads();
    }
    {
        LAS float* scr = (LAS float*)(lds + wave * 16384);
        for (int d = 0; d < 22; ++d) {
            const float* src; bf16_t* dst; int K, N, mode = 0, row_off = 0;
            if (d < 2)       { src = P.in[I_AWQKV] + (size_t)d * 1024 * 1536;        dst = (bf16_t*)(ws + W_AQKV) + (size_t)d * 1536 * 1024;        K = 1024; N = 1536; }
            else if (d < 4)  { src = P.in[I_AWO] + (size_t)(d - 2) * 1024 * 1024;    dst = (bf16_t*)(ws + W_AWO) + (size_t)(d - 2) * 1024 * 1024;    K = 1024; N = 1024; }
            else if (d < 6)  { src = P.in[I_BWDOWN] + (size_t)(d - 4) * 1024 * 800;  dst = (bf16_t*)(ws + W_BDN) + (size_t)(d - 4) * 1024 * 1024;    K = 1024; N = 800; }
            else if (d < 8)  { src = P.in[I_BWUQ] + (size_t)(d - 6) * 512 * 1536;    dst = (bf16_t*)(ws + W_BUQ) + (size_t)(d - 6) * 1536 * 512;     K = 512; N = 1536; }
            else if (d < 10) { src = P.in[I_BWUK] + (size_t)(d - 8) * 256 * 1024;    dst = (bf16_t*)(ws + W_BUKV) + (size_t)(d - 8) * 2048 * 256;    K = 256; N = 1024; }
            else if (d < 12) { src = P.in[I_BWUV] + (size_t)(d - 10) * 256 * 1024;   dst = (bf16_t*)(ws + W_BUKV) + (size_t)(d - 10) * 2048 * 256;   K = 256; N = 1024; row_off = 1024; }
            else if (d < 14) { src = P.in[I_BWO] + (size_t)(d - 12) * 1024 * 1024;   dst = (bf16_t*)(ws + W_BWO) + (size_t)(d - 12) * 1024 * 1024;   K = 1024; N = 1024; }
            else if (d < 18) { src = P.in[I_FWIN] + (size_t)(d - 14) * 1024 * 5632;  dst = (bf16_t*)(ws + W_FIN) + (size_t)(d - 14) * 5632 * 1024;   K = 1024; N = 5632; mode = 1; }
            else             { src = P.in[I_FWOUT] + (size_t)(d - 18) * 2816 * 1024; dst = (bf16_t*)(ws + W_FOUT) + (size_t)(d - 18) * 1024 * 2816;  K = 2816; N = 1024; }
            transpose_matrix(src, K, N, dst, mode, row_off, scr, gw, NGW, lane);
        }
        const int gt = blockIdx.x * NTHR + tid, NGT = G * NTHR;
        for (int e = gt; e < 2 * 224 * 128; e += NGT) { const int li = e / (224 * 128), r = (e / 128) % 224, c = e & 127;
            *(u32x4*)((bf16_t*)(ws + W_BDN) + (size_t)li * 1024 * 1024 + (size_t)(800 + r) * 1024 + c * 8) = (u32x4){0u, 0u, 0u, 0u}; }
        for (int e = gt; e < SEQ * 32; e += NGT) { const int s = e >> 5, p = e & 31; const float pos = (float)(p < 16 ? (s >> 6) : (s & 63));
            const float inv = exp2f(-(float)(p & 15) * (13.287712379549449f / 16.0f)); const float ang = pos * inv;
            ((float*)(ws + WS_ROPEA))[(size_t)e * 2] = cosf(ang); ((float*)(ws + WS_ROPEA))[(size_t)e * 2 + 1] = sinf(ang); }
        for (int e = gt; e < SEQ * 16; e += NGT) { const int s = e >> 4, p = e & 15; const float pos = (float)(p < 8 ? (s >> 6) : (s & 63));
            const float inv = exp2f(-(float)(p & 7) * (13.287712379549449f / 8.0f)); const float ang = pos * inv;
            ((float*)(ws + WS_ROPEB))[(size_t)e * 2] = cosf(ang); ((float*)(ws + WS_ROPEB))[(size_t)e * 2 + 1] = sinf(ang); }
    }
}

__device__ __forceinline__ void norm_phase(const Params& P, unsigned char* ws, int layer, int which, int nrows, bool first, int lane, int wave, const float* pend_part, int pend_ns, const float* pend_gate) {
    const int gw = blockIdx.x * NWAVES + wave, NGW = gridDim.x * NWAVES;
    const float* g = (which == 0 ? P.in[I_N1G] : P.in[I_N2G]) + layer * DM;
    bf16_t* H = (bf16_t*)(ws + WS_H);
    for (int row = MLAT + gw; row < nrows; row += NGW) {
        float* wrow = (float*)(ws + WS_Y) + (size_t)(row - MLAT) * DM;
        const float* srow = first ? P.in[I_CTX] + (size_t)(row - MLAT) * DM : wrow;
        const float* mod = (const float*)(ws + WS_MOD) + (size_t)(layer * 9 + 8) * 6144 + which * 3 * DM;
        f32x4 v[4]; float ss = 0.f;
#pragma unroll
        for (int j = 0; j < 4; ++j) v[j] = *(const f32x4*)(srow + 4 * lane + 256 * j);
        if (pend_ns > 0) {
#pragma unroll
            for (int j = 0; j < 4; ++j) { const int col = 4 * lane + 256 * j; f32x4 a = (f32x4){0.f, 0.f, 0.f, 0.f};
                for (int ks = 0; ks < pend_ns; ++ks) a = a + *(const f32x4*)(pend_part + ((size_t)ks * MCTX + (row - MLAT)) * DM + col);
                v[j] = v[j] + *(const f32x4*)(pend_gate + col) * a; }
        }
#pragma unroll
        for (int j = 0; j < 4; ++j) ss += (v[j][0] * v[j][0] + v[j][1] * v[j][1]) + (v[j][2] * v[j][2] + v[j][3] * v[j][3]);
        const float rstd = rsqrtf(wave_sum(ss, lane) * (1.0f / DM) + EPS);
#pragma unroll
        for (int j = 0; j < 4; ++j) {
            const int col = 4 * lane + 256 * j;
            const f32x4 g4 = *(const f32x4*)(g + col), sh = *(const f32x4*)(mod + col), sc = *(const f32x4*)(mod + DM + col);
            const f32x4 h = (v[j] * rstd) * g4 * (sc + 1.0f) + sh;
            u32x2 w; w.x = cvt_pk_bf16(h[0], h[1]); w.y = cvt_pk_bf16(h[2], h[3]);
            *(u32x2*)(H + (size_t)row * DM + col) = w;
            if (first || pend_ns > 0) *(f32x4*)(wrow + col) = v[j];
        }
    }
    constexpr int NR = 2;
    bf16_t* XB = (bf16_t*)((unsigned char*)P.out + XB_OFF);
    for (int row0 = gw; row0 < MLAT; row0 += NR * NGW) {
        f32x4 v[NR][2][2]; float ss[NR];
#pragma unroll
        for (int r = 0; r < NR; ++r) { const int row = row0 + r * NGW; ss[r] = 0.f;
#pragma unroll
            for (int j = 0; j < 2; ++j) { const int col = 8 * lane + 512 * j;
                if (first) { v[r][j][0] = *(const f32x4*)(P.in[I_X] + (size_t)row * DM + col); v[r][j][1] = *(const f32x4*)(P.in[I_X] + (size_t)row * DM + col + 4); }
                else { const u32x4 w = *(const u32x4*)(XB + (size_t)row * DM + col); v[r][j][0] = bf4_to_f32((u32x2){w.x, w.y}); v[r][j][1] = bf4_to_f32((u32x2){w.z, w.w}); } } }
#pragma unroll
        for (int r = 0; r < NR; ++r)
#pragma unroll
            for (int j = 0; j < 2; ++j)
#pragma unroll
                for (int q = 0; q < 2; ++q) ss[r] += (v[r][j][q][0] * v[r][j][q][0] + v[r][j][q][1] * v[r][j][q][1]) + (v[r][j][q][2] * v[r][j][q][2] + v[r][j][q][3] * v[r][j][q][3]);
#pragma unroll
        for (int r = 0; r < NR; ++r) { const int row = row0 + r * NGW;
            const float rstd = rsqrtf(wave_sum(ss[r], lane) * (1.0f / DM) + EPS);
            const float* mod = (const float*)(ws + WS_MOD) + (size_t)(layer * 9 + (row >> 12)) * 6144 + which * 3 * DM;
#pragma unroll
            for (int j = 0; j < 2; ++j) { const int col = 8 * lane + 512 * j; u32x4 hw, xw;
#pragma unroll
                for (int q = 0; q < 2; ++q) {
                    const f32x4 g4 = *(const f32x4*)(g + col + 4 * q), sh = *(const f32x4*)(mod + col + 4 * q), sc = *(const f32x4*)(mod + DM + col + 4 * q);
                    const f32x4 h = (v[r][j][q] * rstd) * g4 * (sc + 1.0f) + sh;
                    if (q == 0) { hw.x = cvt_pk_bf16(h[0], h[1]); hw.y = cvt_pk_bf16(h[2], h[3]); xw.x = cvt_pk_bf16(v[r][j][q][0], v[r][j][q][1]); xw.y = cvt_pk_bf16(v[r][j][q][2], v[r][j][q][3]); }
                    else { hw.z = cvt_pk_bf16(h[0], h[1]); hw.w = cvt_pk_bf16(h[2], h[3]); xw.z = cvt_pk_bf16(v[r][j][q][0], v[r][j][q][1]); xw.w = cvt_pk_bf16(v[r][j][q][2], v[r][j][q][3]); }
                }
                *(u32x4*)(H + (size_t)row * DM + col) = hw;
                if (first) *(u32x4*)(XB + (size_t)row * DM + col) = xw;
            } }
    }
}

__device__ __forceinline__ void rownorm_phase(const Params& P, unsigned char* ws, int j, int lane, int wave) {
    const int gw = blockIdx.x * NWAVES + wave, NGW = gridDim.x * NWAVES;
    const bf16_t* D = (const bf16_t*)(ws + RB_D); bf16_t* CQ = (bf16_t*)(ws + RB_CQ); bf16_t* CKV = (bf16_t*)(ws + RB_CKV); bf16_t* Kd = (bf16_t*)(ws + RB_K);
    const float* qg = P.in[I_BQNG] + j * 512; const float* kg = P.in[I_BKVNG] + j * 256; const float* rope = (const float*)(ws + WS_ROPEB);
    for (int row = gw; row < MTOT; row += NGW) {
        const bool lat = row < MLAT; const int s = row & (SEQ - 1);
        const bf16_t* d = D + (size_t)row * DM;
        const u32x4 aw = *(const u32x4*)(d + 8 * lane); const u32x2 cw2 = *(const u32x2*)(d + 512 + 4 * lane);
        u32x2 kw = (u32x2){0u, 0u}; if (lane < 8) kw = *(const u32x2*)(d + 768 + 4 * lane);
        const f32x4 a0 = bf4_to_f32((u32x2){aw.x, aw.y}), a1 = bf4_to_f32((u32x2){aw.z, aw.w}), c0 = bf4_to_f32(cw2);
        f32x4 kr = bf4_to_f32(kw);
        const float sq = wave_sum((a0[0] * a0[0] + a0[1] * a0[1]) + (a0[2] * a0[2] + a0[3] * a0[3]) + (a1[0] * a1[0] + a1[1] * a1[1]) + (a1[2] * a1[2] + a1[3] * a1[3]), lane);
        const float sk = wave_sum((c0[0] * c0[0] + c0[1] * c0[1]) + (c0[2] * c0[2] + c0[3] * c0[3]), lane);
        const float rq = rsqrtf(sq * (1.0f / 512.0f) + EPS), rk = rsqrtf(sk * (1.0f / 256.0f) + EPS);
        { const f32x4 g0 = *(const f32x4*)(qg + 8 * lane), g1 = *(const f32x4*)(qg + 8 * lane + 4), g2 = *(const f32x4*)(kg + 4 * lane);
          const f32x4 h0 = a0 * rq * g0, h1 = a1 * rq * g1, h2 = c0 * rk * g2;
          u32x4 w4; w4.x = cvt_pk_bf16(h0[0], h0[1]); w4.y = cvt_pk_bf16(h0[2], h0[3]); w4.z = cvt_pk_bf16(h1[0], h1[1]); w4.w = cvt_pk_bf16(h1[2], h1[3]); *(u32x4*)(CQ + (size_t)row * 512 + 8 * lane) = w4;
          u32x2 w; w.x = cvt_pk_bf16(h2[0], h2[1]); w.y = cvt_pk_bf16(h2[2], h2[3]); *(u32x2*)(CKV + (size_t)row * 256 + 4 * lane) = w; }
        if (lat && lane < 8) { const f32x4 cs = *(const f32x4*)(rope + ((size_t)s * 16 + 2 * lane) * 2);
            kr = (f32x4){kr[0] * cs[0] - kr[1] * cs[1], kr[0] * cs[1] + kr[1] * cs[0], kr[2] * cs[2] - kr[3] * cs[3], kr[2] * cs[3] + kr[3] * cs[2]}; }
        const unsigned k0 = cvt_pk_bf16(kr[0], kr[1]), k1 = cvt_pk_bf16(kr[2], kr[3]);
        const unsigned b0 = (unsigned)__builtin_amdgcn_ds_bpermute((lane & 7) << 2, (int)k0), b1 = (unsigned)__builtin_amdgcn_ds_bpermute((lane & 7) << 2, (int)k1);
#pragma unroll
        for (int it = 0; it < 2; ++it) { const int h = (lane >> 3) + 8 * it; u32x2 w; w.x = b0; w.y = b1; *(u32x2*)(Kd + (size_t)row * 1536 + h * 96 + 64 + 4 * (lane & 7)) = w; }
    }
}

__device__ __forceinline__ void fixup_phase(const Params& P, unsigned char* ws, int layer, int nchunks, int lane, int wave) {
    const int gw = blockIdx.x * NWAVES + wave, NGW = gridDim.x * NWAVES;
    const float* E = (const float*)(ws + RF_EDGE); bf16_t* U = (bf16_t*)(ws + RF_U);
    const float* cw = P.in[I_FCW] + (size_t)layer * 3 * DFF;
    for (int it = gw; it < nchunks * 11; it += NGW) {
        const int c = it / 11, fb = it % 11, f = fb * 256 + 4 * lane;
        const bool start = c < MLAT / 64 ? ((c & 63) == 0) : (((c - MLAT / 64) & 3) == 0);
        if (start) continue;
        const float* eb = E + ((size_t)((c - 1) * 2 + 1) * 3) * DFF + f;
        const float* et = E + ((size_t)(c * 2) * 3) * DFF + f;
        const f32x4 ab = *(const f32x4*)eb, pb = *(const f32x4*)(eb + DFF), vb = *(const f32x4*)(eb + 2 * DFF);
        const f32x4 at = *(const f32x4*)et, pt = *(const f32x4*)(et + DFF), vt = *(const f32x4*)(et + 2 * DFF);
        const f32x4 w0 = *(const f32x4*)(cw + f), w2 = *(const f32x4*)(cw + 2 * DFF + f);
        const f32x4 xb = pb + w2 * at, xt = pt + w0 * ab;
        u32x2 w;
        w.x = cvt_pk_bf16(silu_f(xb[0]) * vb[0], silu_f(xb[1]) * vb[1]); w.y = cvt_pk_bf16(silu_f(xb[2]) * vb[2], silu_f(xb[3]) * vb[3]);
        *(u32x2*)(U + (size_t)(c * 64 - 1) * DFF + f) = w;
        w.x = cvt_pk_bf16(silu_f(xt[0]) * vt[0], silu_f(xt[1]) * vt[1]); w.y = cvt_pk_bf16(silu_f(xt[2]) * vt[2], silu_f(xt[3]) * vt[3]);
        *(u32x2*)(U + (size_t)(c * 64) * DFF + f) = w;
    }
}

constexpr float ATT_THR = 8.0f;
constexpr int AT_KB = 16384, AT_VB = 16384, AT_BUF = AT_KB + AT_VB;
template <int DQK, bool WIN, bool SAFE>
__device__ __forceinline__ bool attn_unit(const Params& P, unsigned char* ws, LAS unsigned char* lds, int layer_j, int u, int tid, int lane, int wave) {
    constexpr int NKS = DQK / 32, CPR = DQK / 8, NQ = 4;
    volatile LAS unsigned* badflag = (volatile LAS unsigned*)(lds + 4 * AT_BUF);
    const bf16_t* Q = (const bf16_t*)(ws + (WIN ? RA_Q : RB_Q)); const bf16_t* Kg = (const bf16_t*)(ws + (WIN ? RA_K : RB_K)); const bf16_t* VT = (const bf16_t*)(ws + (WIN ? RA_VT : RB_VT));
    bf16_t* O = (bf16_t*)(ws + WS_H);
    constexpr int QP = WIN ? 1024 : 1536, KP = WIN ? 256 : 1536, NHKV = WIN ? 4 : 16;
    const int fr = lane & 15, fq = lane >> 4;
    {
        const bool ctxq = u >= 1024;
        int b, hq, q0, nq;
        if (!ctxq) { q0 = (u & 7) * 512; hq = (u >> 3) & 15; b = u >> 7; nq = 512; } else { const int uc = u - 1024; hq = uc & 15; b = uc >> 4; q0 = 0; nq = 256; }
        const int hkv = WIN ? (hq >> 2) : hq;
        int s_lo = 0, s_hi = SEQ;
        if (WIN) { s_lo = q0 - 128 < 0 ? 0 : q0 - 128; s_hi = q0 + 512 + 128 > SEQ ? SEQ : q0 + 512 + 128; }
        const int nt = ctxq ? 4 : 4 + (s_hi - s_lo) / 64;
        const int qw = q0 + 64 * wave;
        const bool active = 64 * wave < nq;
        const size_t qrow0 = (ctxq ? (size_t)MLAT + b * CTXL : (size_t)b * SEQ) + qw;
        bf16x8 qf[NQ][NKS];
        if (active) {
#pragma unroll
            for (int qb = 0; qb < NQ; ++qb)
#pragma unroll
                for (int ks = 0; ks < NKS; ++ks) qf[qb][ks] = *(const bf16x8*)(Q + (qrow0 + 16 * qb + fr) * QP + hq * DQK + 32 * ks + 8 * fq);
        }
        bf16x8 ones8 = (bf16x8){0x3F80, 0x3F80, 0x3F80, 0x3F80, 0x3F80, 0x3F80, 0x3F80, 0x3F80}; asm volatile("" : "+v"(ones8));
        f32x4 o[4][NQ]; f32x4 negm[NQ]; f32x4 lacc[NQ];
        float m0 = 0.f, l0 = 0.f;
        if (WIN) { m0 = P.in[I_ASINK][layer_j * 16 + hq] * LOG2E; l0 = SAFE ? 1.f : __builtin_amdgcn_exp2f(m0); }
#pragma unroll
        for (int qb = 0; qb < NQ; ++qb) { negm[qb] = (f32x4){-m0, -m0, -m0, -m0}; lacc[qb] = (f32x4){l0, l0, l0, l0};
#pragma unroll
            for (int dv = 0; dv < 4; ++dv) o[dv][qb] = (f32x4){0.f, 0.f, 0.f, 0.f}; }
#define AT_KP(t) ((t) < 4 ? 64 * (t) : CTXL + s_lo + 64 * ((t) - 4))
#define AT_SWZ(r) ((((r) >> 3) & 3) << 2 | ((r) & 3))
#define AT_DMA(t) do { int ln_ = lane; asm volatile("" : "+v"(ln_)); const int kp0_ = AT_KP(t); const size_t kr0_ = kp0_ < CTXL ? (size_t)MLAT + b * CTXL + kp0_ : (size_t)b * SEQ + (kp0_ - CTXL); \
        LAS unsigned char* bb_ = lds + ((t) & 3) * AT_BUF + wave * 2048; \
        _Pragma("unroll") for (int i_ = 0; i_ < 2; ++i_) { const int p_ = wave * 2048 + i_ * 1024 + ln_ * 16, r_ = p_ >> 8, cs_ = (p_ >> 4) & 15; \
            const int ck_ = cs_ ^ AT_SWZ(r_), cv_ = cs_ ^ (r_ & 15); \
            if (ck_ < CPR) __builtin_amdgcn_global_load_lds((const unsigned*)(Kg + (kr0_ + r_) * KP + hkv * DQK + ck_ * 8), (LAS unsigned*)(bb_ + i_ * 1024), 16, 0, 0); \
            if (cv_ < 8) __builtin_amdgcn_global_load_lds((const unsigned*)(VT + ((size_t)(b * NHKV + hkv) * 64 + r_) * KPB + kp0_ + cv_ * 8), (LAS unsigned*)(bb_ + AT_KB + i_ * 1024), 16, 0, 0); } } while (0)
#define AT_BAR() do { asm volatile("s_waitcnt lgkmcnt(0)" ::: "memory"); __builtin_amdgcn_s_barrier(); asm volatile("" ::: "memory"); } while (0)
        asm volatile("s_waitcnt vmcnt(0)" ::: "memory");
        __syncthreads();
        AT_DMA(0); if (nt > 1) AT_DMA(1);
        if (tid == 0) badflag[0] = 0u;
        asm volatile("s_waitcnt vmcnt(0)" ::: "memory");
        AT_BAR();
        for (int t2 = 0; t2 < nt; t2 += 2) {
            if (t2 + 2 < nt) { AT_DMA(t2 + 2); AT_DMA(t2 + 3); }
          for (int t = t2; t < t2 + 2; ++t) {
            bool doit = active, need_mask = false; int k0 = 0;
            if (WIN && t >= 4) { k0 = s_lo + 64 * (t - 4);
                if (k0 > qw + 63 + 128 || k0 + 63 < qw - 128) doit = false;
                need_mask = !(k0 + 63 - qw <= 128 && qw + 63 - k0 <= 128); }
            if (doit) {
                int fr = lane & 15, fq = lane >> 4; asm volatile("" : "+v"(fr), "+v"(fq));
                const LAS unsigned char* kbase = lds + (t & 3) * AT_BUF; const LAS unsigned char* vbase = kbase + AT_KB;
#pragma unroll
                for (int g = 0; g < 2; ++g) {
                    f32x4 sc[2][NQ];
#pragma unroll
                    for (int kb = 0; kb < 2; ++kb)
#pragma unroll
                        for (int qb = 0; qb < NQ; ++qb) sc[kb][qb] = SAFE ? negm[qb] : (f32x4){0.f, 0.f, 0.f, 0.f};
                    bf16x8 kfa[NKS][2];
#pragma unroll
                    for (int ks = 0; ks < NKS; ++ks)
#pragma unroll
                        for (int kb = 0; kb < 2; ++kb) { const int r = 32 * g + 8 * (fr >> 2) + 4 * kb + (fr & 3);
                            kfa[ks][kb] = *(const LAS bf16x8*)(kbase + r * 256 + (((4 * ks + fq) ^ AT_SWZ(r)) << 4)); }
                    __builtin_amdgcn_sched_barrier(0);
#pragma unroll
                    for (int ks = 0; ks < NKS; ++ks)
#pragma unroll
                        for (int kb = 0; kb < 2; ++kb)
#pragma unroll
                            for (int qb = 0; qb < NQ; ++qb) sc[kb][qb] = __builtin_amdgcn_mfma_f32_16x16x32_bf16(kfa[ks][kb], qf[qb][ks], sc[kb][qb], 0, 0, 0);
                    if (WIN && need_mask) {
#pragma unroll
                        for (int qb = 0; qb < NQ; ++qb) { const int qpos = qw + 16 * qb + fr;
#pragma unroll
                            for (int kb = 0; kb < 2; ++kb)
#pragma unroll
                                for (int j = 0; j < 4; ++j) { const int dlt = qpos - (k0 + 32 * g + 8 * fq + 4 * kb + j); if (dlt > 128 || dlt < -128) sc[kb][qb][j] = -1e30f; } }
                    }
                    const bool first = !WIN && t == 0 && g == 0;
                    if (SAFE) {
                    float lmx[NQ], anymx = -1e30f;
#pragma unroll
                    for (int qb = 0; qb < NQ; ++qb) {
                        lmx[qb] = fmaxf(fmaxf(fmaxf(fmaxf(sc[0][qb][0], sc[0][qb][1]), sc[0][qb][2]), fmaxf(fmaxf(sc[0][qb][3], sc[1][qb][0]), sc[1][qb][1])), fmaxf(fmaxf(sc[1][qb][2], sc[1][qb][3]), -1e30f));
                        anymx = fmaxf(anymx, lmx[qb]);
                    }
                    if (first || __builtin_amdgcn_ballot_w64(anymx > ATT_THR) != 0ull) {
#pragma unroll
                        for (int qb = 0; qb < NQ; ++qb) {
                            float mx = lmx[qb]; mx = fmaxf(mx, shfl_f(mx, lane ^ 16)); mx = fmaxf(mx, shfl_f(mx, lane ^ 32));
                            const float delta = first ? mx : fmaxf(mx, 0.f);
                            const float alpha = first ? 1.f : __builtin_amdgcn_exp2f(-delta);
                            negm[qb] = negm[qb] - delta; sc[0][qb] = sc[0][qb] - delta; sc[1][qb] = sc[1][qb] - delta;
                            lacc[qb] = lacc[qb] * alpha;
#pragma unroll
                            for (int dv = 0; dv < 4; ++dv) o[dv][qb] = o[dv][qb] * alpha;
                        }
                    }
                    }
                    bf16x8 vfr[4];
#pragma unroll
                    for (int dv = 0; dv < 4; ++dv) vfr[dv] = *(const LAS bf16x8*)(vbase + (16 * dv + fr) * 256 + (((4 * g + fq) ^ fr) << 4));
                    __builtin_amdgcn_sched_barrier(0);
                    bf16x8 pf[NQ];
#pragma unroll
                    for (int qb = 0; qb < NQ; ++qb) {
                        float p[8];
#pragma unroll
                        for (int kb = 0; kb < 2; ++kb)
#pragma unroll
                            for (int j = 0; j < 4; ++j) p[4 * kb + j] = __builtin_amdgcn_exp2f(sc[kb][qb][j]);
                        u32x4 pk; pk.x = cvt_pk_v(p[0], p[1]); pk.y = cvt_pk_v(p[2], p[3]); pk.z = cvt_pk_v(p[4], p[5]); pk.w = cvt_pk_v(p[6], p[7]);
                        pf[qb] = __builtin_bit_cast(bf16x8, pk);
                        lacc[qb] = __builtin_amdgcn_mfma_f32_16x16x32_bf16(ones8, pf[qb], lacc[qb], 0, 0, 0);
                    }
#pragma unroll
                    for (int dv = 0; dv < 4; ++dv) {
#pragma unroll
                        for (int qb = 0; qb < NQ; ++qb) o[dv][qb] = __builtin_amdgcn_mfma_f32_16x16x32_bf16(vfr[dv], pf[qb], o[dv][qb], 0, 0, 0);
                    }
                }
            }
          }
            asm volatile("s_waitcnt vmcnt(0)" ::: "memory");
            AT_BAR();
        }
        bool wbad = false;
        if (active) {
#pragma unroll
            for (int qb = 0; qb < NQ; ++qb) {
                const float l = lacc[qb][0];
                if (!SAFE) wbad = wbad || !(l > 1e-30f && l < 1e30f);
                const float inv = 1.0f / l;
                bf16_t* op = O + (qrow0 + 16 * qb + fr) * DM + hq * 64 + 4 * fq;
#pragma unroll
                for (int dv = 0; dv < 4; ++dv) { const f32x4 v = o[dv][qb] * inv; u32x2 w; w.x = cvt_pk_v(v[0], v[1]); w.y = cvt_pk_v(v[2], v[3]); *(u32x2*)(op + 16 * dv) = w; }
            }
        }
#undef AT_DMA
#undef AT_BAR
#undef AT_KP
#undef AT_SWZ
        if (SAFE) return false;
        if (__builtin_amdgcn_ballot_w64(wbad) != 0ull && lane == 0) badflag[0] = 1u;
        __syncthreads();
        return badflag[0] != 0u;
    }
}
template <int DQK, bool WIN>
__device__ __forceinline__ void attn_phase(const Params& P, unsigned char* ws, LAS unsigned char* lds, int layer_j, bool with_ctx, int tid, int lane, int wave) {
    const int nunits = 1024 + (with_ctx ? 128 : 0);
    const int G_ = gridDim.x, bx_ = blockIdx.x, vcu = (G_ % 8 == 0) ? (bx_ % 8) * (G_ / 8) + bx_ / 8 : bx_;
    for (int u = vcu; u < nunits; u += G_) {
        if (attn_unit<DQK, WIN, false>(P, ws, lds, layer_j, u, tid, lane, wave)) (void)attn_unit<DQK, WIN, true>(P, ws, lds, layer_j, u, tid, lane, wave);
    }
    __syncthreads();
}

#define XB_TMO      128
#define XB_XCNT(j)  (256  + 64 * (j))
#define XB_XSUB(j)  (1280 + 64 * (j))
#define XB_XGEN(j)  (2304 + 64 * (j))
#define XB_TOP      3328
#define XB_TOPGEN   3392
#define XCD_BAR_WORDS 3456
#define XB_SPIN_CAP (1u << 18)

__device__ __forceinline__ unsigned xb_ld(unsigned* p)              { return __hip_atomic_load(p, __ATOMIC_RELAXED, __HIP_MEMORY_SCOPE_AGENT); }
__device__ __forceinline__ unsigned xb_add(unsigned* p, unsigned v) { return __hip_atomic_fetch_add(p, v, __ATOMIC_RELAXED, __HIP_MEMORY_SCOPE_AGENT); }
__device__ __forceinline__ unsigned xb_xcc_id() { return (unsigned)__builtin_amdgcn_s_getreg((3 << 11) | 20) & 0xFu; }
#define XB_SPIN(cond, bar) do { unsigned _sp = 0; while (cond) { __builtin_amdgcn_s_sleep(1); \
    if ((++_sp & 255u) == 0u) { if (xb_ld(&(bar)[XB_TMO])) break; if (_sp > XB_SPIN_CAP) { atomicAdd(&(bar)[XB_TMO], 1u); break; } } } } while (0)

struct XcdBarrier {
    unsigned* bar; unsigned x;
    volatile LAS unsigned* st;
};

__device__ __forceinline__ XcdBarrier xcd_barrier_post(unsigned* bar, volatile LAS unsigned* st) {
    XcdBarrier b; b.bar = bar; b.x = xb_xcc_id(); b.st = st;
    if (threadIdx.x == 0) (void)xb_add(&bar[XB_XCNT(b.x)], 1u);
    return b;
}
__device__ __forceinline__ void xcd_barrier_complete(unsigned* bar, unsigned x, unsigned& nloc, unsigned& nx) {
    const unsigned G = gridDim.x * gridDim.y * gridDim.z;
    unsigned sum, cnt, mine, sp = 0u;
    for (;;) {
        sum = 0u; cnt = 0u; mine = 0u;
#pragma unroll
        for (unsigned j = 0; j < 16; ++j) { const unsigned c = xb_ld(&bar[XB_XCNT(j)]); sum += c; cnt += (c > 0u) ? 1u : 0u; mine = (j == x) ? c : mine; }
        if (sum == G) break;
        __builtin_amdgcn_s_sleep(1);
        if ((++sp & 255u) == 0u) { if (xb_ld(&bar[XB_TMO])) break; if (sp > XB_SPIN_CAP) { atomicAdd(&bar[XB_TMO], 1u); break; } }
    }
    nloc = mine > 0u ? mine : 1u; nx = cnt > 0u ? cnt : 1u;
}

__device__ __forceinline__ void xcd_barrier(const XcdBarrier& b) {
    asm volatile("s_waitcnt vmcnt(0)" ::: "memory");
    __syncthreads();
    if (threadIdx.x == 0) {
        unsigned* bar = b.bar;
        __builtin_amdgcn_s_waitcnt(0);
        unsigned nloc = b.st[0], nx = b.st[1];
        if (nloc == 0u) { xcd_barrier_complete(bar, b.x, nloc, nx); b.st[0] = nloc; b.st[1] = nx; }
        const unsigned old = xb_add(&bar[XB_XSUB(b.x)], 1u);
        const unsigned gen = old / nloc;
        if (old + 1u == (gen + 1u) * nloc) {
            __builtin_amdgcn_fence(__ATOMIC_RELEASE, "agent");
            asm volatile("s_waitcnt vmcnt(0)" ::: "memory");
            const unsigned og = xb_add(&bar[XB_TOP], 1u);
            const unsigned tg = og / nx;
            if (og + 1u == (tg + 1u) * nx) xb_add(&bar[XB_TOPGEN], 1u);
            else XB_SPIN(xb_ld(&bar[XB_TOPGEN]) == tg, bar);
            __builtin_amdgcn_fence(__ATOMIC_ACQUIRE, "agent");
            xb_add(&bar[XB_XGEN(b.x)], 1u);
            asm volatile("s_waitcnt vmcnt(0)" ::: "memory");
        } else {
            XB_SPIN(xb_ld(&bar[XB_XGEN(b.x)]) == gen, bar);
            __builtin_amdgcn_fence(__ATOMIC_ACQUIRE, "agent");
            asm volatile("s_waitcnt vmcnt(0)" ::: "memory");
        }
    }
    __syncthreads();
}


__device__ __forceinline__ void final_norm(const Params& P, const XcdBarrier& xbar, int lane, int wave) {
    const int gw = blockIdx.x * NWAVES + wave, NGW = gridDim.x * NWAVES;
    const float* g = P.in[I_FINALG];
    const bf16_t* XB = (const bf16_t*)((unsigned char*)P.out + XB_OFF);
#define FN_LOAD(vv, row) do { _Pragma("unroll") for (int j = 0; j < 2; ++j) { const u32x4 w_ = *(const u32x4*)(XB + (size_t)(row) * DM + 8 * lane + 512 * j); vv[j][0] = bf4_to_f32((u32x2){w_.x, w_.y}); vv[j][1] = bf4_to_f32((u32x2){w_.z, w_.w}); } } while (0)
#define FN_STORE(vv, row) do { float ss_ = 0.f; _Pragma("unroll") for (int j = 0; j < 2; ++j) _Pragma("unroll") for (int q = 0; q < 2; ++q) ss_ += (vv[j][q][0] * vv[j][q][0] + vv[j][q][1] * vv[j][q][1]) + (vv[j][q][2] * vv[j][q][2] + vv[j][q][3] * vv[j][q][3]); \
        const float rstd_ = rsqrtf(wave_sum(ss_, lane) * (1.0f / DM) + EPS); \
        _Pragma("unroll") for (int j = 0; j < 2; ++j) _Pragma("unroll") for (int q = 0; q < 2; ++q) { const int col_ = 8 * lane + 512 * j + 4 * q; *(f32x4*)(P.out + (size_t)(row) * DM + col_) = (vv[j][q] * rstd_) * *(const f32x4*)(g + col_); } } while (0)
    for (int row = gw; row < 16384; row += NGW) { f32x4 v[2][2]; FN_LOAD(v, row); FN_STORE(v, row); }
    f32x4 vc[8][2][2];
#pragma unroll
    for (int k = 0; k < 8; ++k) { const int row = 16384 + gw + k * NGW; if (row < MLAT) FN_LOAD(vc[k], row); }
    xcd_barrier(xbar);
#pragma unroll
    for (int k = 0; k < 8; ++k) { const int row = 16384 + gw + k * NGW; if (row < MLAT) FN_STORE(vc[k], row); }
#undef FN_LOAD
#undef FN_STORE
}

#ifndef DBL_MASK
#define DBL_MASK 0
#endif
enum PhType { PH_PRO = 0, PH_NORM1, PH_NORM2, PH_G_QKVA, PH_ATT_A, PH_G_WOA, PH_G_D, PH_ROWNORM, PH_G_QB, PH_G_KVB, PH_ATT_B, PH_G_WOB, PH_G_FFN1, PH_FIXUP, PH_G_FFN2, PH_FINAL };
constexpr int NPH = 1 + 8 + 11 + 8 + 11 + 1;
__device__ __forceinline__ void phase_decode(int ph, int& type, int& layer, bool& nosync) {
    nosync = false; layer = 0;
    if (ph == 0) { type = PH_PRO; return; }
    if (ph == NPH - 1) { type = PH_FINAL; return; }
    int r = ph - 1; const int pair = r / 19; r -= pair * 19;
    if (r < 8) { layer = 2 * pair;
        type = r == 0 ? PH_NORM1 : r == 1 ? PH_G_QKVA : r == 2 ? PH_ATT_A : r == 3 ? PH_G_WOA : r == 4 ? PH_NORM2 : r == 5 ? PH_G_FFN1 : r == 6 ? PH_FIXUP : PH_G_FFN2;
    } else { r -= 8; layer = 2 * pair + 1;
        type = r == 0 ? PH_NORM1 : r == 1 ? PH_G_D : r == 2 ? PH_ROWNORM : r == 3 ? PH_G_QB : r == 4 ? PH_G_KVB : r == 5 ? PH_ATT_B : r == 6 ? PH_G_WOB : r == 7 ? PH_NORM2 : r == 8 ? PH_G_FFN1 : r == 9 ? PH_FIXUP : PH_G_FFN2;
        nosync = (r == 3);
    }
}

__global__ void __launch_bounds__(NTHR, 2) fwd_megakernel(Params P) {
    extern __shared__ __attribute__((aligned(16))) unsigned char lds_raw[];
    LAS unsigned char* lds = (LAS unsigned char*)lds_raw;
    cg::grid_group grid = cg::this_grid();
    { volatile LAS unsigned* misc = (volatile LAS unsigned*)(lds + 131072 + 512); if (threadIdx.x < 4) misc[threadIdx.x] = 0u; __syncthreads(); }
    const XcdBarrier xbar = xcd_barrier_post((unsigned*)(P.ws + WS_CTL), (volatile LAS unsigned*)(lds + 131072 + 512));
    for (int ph = P.ph_lo; ph < P.ph_hi; ++ph) {
        int type, layer; bool nosync; phase_decode(ph, type, layer, nosync);
        for (int rep = 0; rep < (((DBL_MASK >> type) & 1) ? 2 : 1); ++rep) {
        if (rep) xcd_barrier(xbar);
        int tid = threadIdx.x; asm volatile("" : "+v"(tid));
        size_t zoff = 0; asm volatile("" : "+s"(zoff)); unsigned char* ws = P.ws + zoff;
        const int lane = tid & 63, wave = __builtin_amdgcn_readfirstlane(tid >> 6);
        const bool with_ctx = layer < DEPTH - 1; const int j = layer >> 1;
        const int Mi = with_ctx ? MTOT : MLAT;
        if (type == PH_PRO) prologue(P, ws, lds, tid, lane, wave);
        else if (type == PH_NORM1) norm_phase(P, ws, layer, 0, MTOT, layer == 0, lane, wave, (const float*)(ws + PART_FFN2), layer > 0 ? NS_FFN2 : 0, (const float*)(ws + WS_MOD) + (size_t)((layer > 0 ? layer - 1 : 0) * 9 + 8) * 6144 + 5 * DM);
        else if (type == PH_NORM2) norm_phase(P, ws, layer, 1, Mi, false, lane, wave, (const float*)(ws + PART_WO), with_ctx ? NS_WO : 0, (const float*)(ws + WS_MOD) + (size_t)(layer * 9 + 8) * 6144 + 2 * DM);
        else if (type == PH_ROWNORM) rownorm_phase(P, ws, j, lane, wave);
        else if (type == PH_FIXUP) fixup_phase(P, ws, layer, Mi / 64, lane, wave);
        else if (type == PH_FINAL) final_norm(P, xbar, lane, wave);
#ifndef NO_ATTA
        else if (type == PH_ATT_A) attn_phase<64, true>(P, ws, lds, j, with_ctx, tid, lane, wave);
#endif
#ifndef NO_ATTB
        else if (type == PH_ATT_B) attn_phase<96, false>(P, ws, lds, j, with_ctx, tid, lane, wave);
#endif
        else {
            pg8::Gemm g; Epi E; E.ws = ws; E.X = P.out; E.layer = layer; E.gidx = 0; E.cw = nullptr; E.cb = nullptr; E.part = nullptr; E.kind = E_RES; int xrows = 0, nsplit = 1;
            const bf16_t* H = (const bf16_t*)(ws + WS_H);
            switch (type) {
            case PH_G_QKVA: g = pg8::Gemm{H, (const bf16_t*)(ws + W_AQKV) + (size_t)j * 1536 * 1024, MTOT, 1536, 1024}; E.kind = E_QKVA; break;
            case PH_G_WOA:  g = pg8::Gemm{H, (const bf16_t*)(ws + W_AWO) + (size_t)j * 1024 * 1024, MLAT, 1024, 1024}; E.kind = E_RES; E.gidx = 2; E.part = (float*)(ws + PART_WO); if (with_ctx) { xrows = MCTX; nsplit = NS_WO; } break;
            case PH_G_D:    g = pg8::Gemm{H, (const bf16_t*)(ws + W_BDN) + (size_t)j * 1024 * 1024, MTOT, 1024, 1024}; E.kind = E_D; break;
            case PH_G_QB:   g = pg8::Gemm{(const bf16_t*)(ws + RB_CQ), (const bf16_t*)(ws + W_BUQ) + (size_t)j * 1536 * 512, Mi, 1536, 512}; E.kind = E_QB; break;
            case PH_G_KVB:  g = pg8::Gemm{(const bf16_t*)(ws + RB_CKV), (const bf16_t*)(ws + W_BUKV) + (size_t)j * 2048 * 256, MTOT, 2048, 256}; E.kind = E_KVB; break;
            case PH_G_WOB:  g = pg8::Gemm{H, (const bf16_t*)(ws + W_BWO) + (size_t)j * 1024 * 1024, MLAT, 1024, 1024}; E.kind = E_RES; E.gidx = 2; E.part = (float*)(ws + PART_WO); if (with_ctx) { xrows = MCTX; nsplit = NS_WO; } break;
            case PH_G_FFN1: g = pg8::Gemm{H, (const bf16_t*)(ws + W_FIN) + (size_t)layer * 5632 * 1024, Mi, 5632, 1024}; E.kind = E_FFN1;
                            E.cw = P.in[I_FCW] + (size_t)layer * 3 * DFF; E.cb = P.in[I_FCB] + (size_t)layer * DFF; break;
            default:        g = pg8::Gemm{(const bf16_t*)(ws + RF_U), (const bf16_t*)(ws + W_FOUT) + (size_t)layer * 1024 * 2816, MLAT, 1024, 2816}; E.kind = E_RES; E.gidx = 5; E.part = (float*)(ws + PART_FFN2); if (with_ctx) { xrows = MCTX; nsplit = NS_FFN2; } break;
            }
            pg8::StaticOrder S; S.init(g.M, g.N, g.K, (int)gridDim.x, (int)blockIdx.x, xrows, nsplit);
            __syncthreads();
#ifndef NO_GEMM
            pg8::gemm_phase<Epi, pg8::StaticOrder, true, true>(lds, g, S, E, tid);
#endif
            __syncthreads();
        }
        }
        if (ph + 1 < P.ph_hi && !nosync) { if (P.ph_lo < 0) grid.sync(); else xcd_barrier(xbar); }
    }
}

extern "C" void kernel_launch(void* const* d_in, const int* in_sizes, int n_in, void* d_out, int out_size, void* d_ws, size_t ws_size, hipStream_t stream) {
    static int grid = 0;
    if (grid == 0) {
        if (n_in != 23 || ws_size < WS_END) { fprintf(stderr, "kernel_launch: unexpected n_in %d / ws_size %zu (need %zu)\n", n_in, ws_size, (size_t)WS_END); grid = -1; return; }
        int dev = 0, cus = 0, per_cu = 0;
        hipGetDevice(&dev); hipDeviceGetAttribute(&cus, hipDeviceAttributeMultiprocessorCount, dev);
        if (hipFuncSetAttribute((const void*)fwd_megakernel, hipFuncAttributeMaxDynamicSharedMemorySize, LDS_BYTES) != hipSuccess) { fprintf(stderr, "kernel_launch: hipFuncSetAttribute failed\n"); grid = -1; return; }
        if (hipOccupancyMaxActiveBlocksPerMultiprocessor(&per_cu, (const void*)fwd_megakernel, NTHR, LDS_BYTES) != hipSuccess || per_cu < 1) { fprintf(stderr, "kernel_launch: occupancy query says %d\n", per_cu); per_cu = 1; }
        (void)hipGetLastError();
        grid = cus * 1;
        if (grid <= 0) grid = 256;
    }
    if (grid < 0) return;
    Params p{};
    for (int i = 0; i < 23; ++i) p.in[i] = (const float*)d_in[i];
    p.out = (float*)d_out; p.ws = (unsigned char*)d_ws; p.ph_lo = 0; p.ph_hi = NPH;
    if (hipMemsetAsync((char*)d_ws + WS_CTL, 0, CTL_BYTES, stream) != hipSuccess) { fprintf(stderr, "kernel_launch: memset failed\n"); return; }
    void* args[] = {&p};
    hipError_t e = hipLaunchCooperativeKernel((const void*)fwd_megakernel, dim3(grid), dim3(NTHR), args, LDS_BYTES, stream);
    if (e != hipSuccess) fprintf(stderr, "cooperative launch failed: %s (grid %d)\n", hipGetErrorString(e), grid);
}
```
